# Optimizing an MI355X kernel written in HIP

```python
import math
import jax, jax.numpy as jnp
from jax import lax
import numpy as np

D_MODEL = 2048
BATCH = 2
SEQ = 8192
DEPTH = 2

MEM_LEN = 256
EPS = 1e-6
DA_HEADS = 8
DA_HEAD_DIM = 64
DA_WIDTH = DA_HEADS * 2 * DA_HEAD_DIM
Q_BLOCK = 128
POOL_WINDOWS = (2, 4, 8, 16)
POOL_WIDTH = D_MODEL // 2
POOL_GROUP = POOL_WIDTH // len(POOL_WINDOWS)
LRU_WIDTH = D_MODEL // 2
LRU_BLOCKS = 8
LRU_BLOCK = LRU_WIDTH // LRU_BLOCKS
CONV_WIDTH = 4
LRU_C = 8.0
MEM_HEADS = 4
MEM_HEAD_DIM = 128
MEM_WIDTH = MEM_HEADS * MEM_HEAD_DIM
N_BRANCH = 4
BRANCH_SIZES = (DA_WIDTH, POOL_WIDTH, LRU_WIDTH, MEM_WIDTH)
BRANCH_OFFSETS = (0, DA_WIDTH, DA_WIDTH + POOL_WIDTH, DA_WIDTH + POOL_WIDTH + LRU_WIDTH, DA_WIDTH + POOL_WIDTH + LRU_WIDTH + MEM_WIDTH)
BRANCH_WIDTH = BRANCH_OFFSETS[-1]
SPLIT_SIZES = (DA_WIDTH, DA_WIDTH, DA_WIDTH, POOL_WIDTH, LRU_WIDTH, MEM_WIDTH, BRANCH_WIDTH, N_BRANCH * D_MODEL)
SPLIT_POINTS = tuple(int(v) for v in np.cumsum(SPLIT_SIZES)[:-1])
N_IN = int(sum(SPLIT_SIZES))

kernel_name = "gated_parallel_hybrid_diffattn_pool_rglru_mem"


def rms_norm(x, g):
    xf = x.astype(jnp.float32)
    y = xf * lax.rsqrt(jnp.mean(xf * xf, axis=-1, keepdims=True) + EPS)
    return (y * g.astype(jnp.float32)).astype(x.dtype)


def block_diag_linear(x, w):
    b, s, _ = x.shape
    g, n, _ = w.shape
    return jnp.einsum('bsgi,gij->bsgj', x.reshape(b, s, g, n), w).reshape(b, s, g * n)


def diff_attention(q, k, v, lam_vecs, subln_g, lambda_init):
    b, s, _ = q.shape
    q = q.reshape(b, s, DA_HEADS, 2, DA_HEAD_DIM)
    k = k.reshape(b, s, DA_HEADS, 2, DA_HEAD_DIM)
    v = v.reshape(b, s, DA_HEADS, 2 * DA_HEAD_DIM)
    lf = lam_vecs.astype(jnp.float32)
    lam = jnp.exp(jnp.sum(lf[0] * lf[1])) - jnp.exp(jnp.sum(lf[2] * lf[3])) + lambda_init
    n_blk = s // Q_BLOCK
    q_blocks = q.reshape(b, n_blk, Q_BLOCK, DA_HEADS, 2, DA_HEAD_DIM).transpose(1, 0, 2, 3, 4, 5)
    k_pos = jnp.arange(s)
    scale = DA_HEAD_DIM ** -0.5

    def one_block(args):
        qb, blk = args
        q_pos = blk * Q_BLOCK + jnp.arange(Q_BLOCK)
        sc = jnp.einsum('bqhcd,bkhcd->bhcqk', qb, k).astype(jnp.float32) * scale
        causal = k_pos[None, :] <= q_pos[:, None]
        sc = jnp.where(causal, sc, -jnp.inf)
        p = jax.nn.softmax(sc, axis=-1)
        p_diff = (p[:, :, 0] - lam * p[:, :, 1]).astype(v.dtype)
        return jnp.einsum('bhqk,bkhe->bqhe', p_diff, v)

    o = lax.map(one_block, (q_blocks, jnp.arange(n_blk)))
    o = o.transpose(1, 0, 2, 3, 4).reshape(b, s, DA_HEADS, 2 * DA_HEAD_DIM)
    o = rms_norm(o, subln_g) * (1.0 - lambda_init)
    return o.reshape(b, s, DA_WIDTH)


def multiscale_pool(x, w_grp, scale):
    b, s, _ = x.shape
    xg = x.reshape(b, s, len(POOL_WINDOWS), POOL_GROUP)
    t = jnp.arange(s)
    outs = []
    for gi, w in enumerate(POOL_WINDOWS):
        xi = xg[:, :, gi].astype(jnp.float32)
        c = jnp.pad(jnp.cumsum(xi, axis=1), ((0, 0), (1, 0), (0, 0)))
        upper = c[:, 1:]
        lower = jnp.pad(c[:, :s - w + 1], ((0, 0), (w - 1, 0), (0, 0)))
        count = jnp.minimum(t + 1, w).astype(jnp.float32)
        mean = (upper - lower) / count[None, :, None]
        outs.append((mean - xi).astype(x.dtype))
    d = jnp.stack(outs, axis=2)
    y = jnp.einsum('bsgi,gij->bsgj', d, w_grp).reshape(b, s, POOL_WIDTH)
    return y * scale


def rg_lru_branch(x, conv_w, conv_b, w_a, b_a, w_x, b_x, lam):
    b, s, _ = x.shape
    xc = lax.conv_general_dilated(x, conv_w[:, None, :], window_strides=(1,),
                                  padding=[(CONV_WIDTH - 1, 0)],
                                  dimension_numbers=('NWC', 'WIO', 'NWC'),
                                  feature_group_count=LRU_WIDTH) + conv_b
    r = jax.nn.sigmoid(block_diag_linear(xc, w_a) + b_a).astype(jnp.float32)
    i = jax.nn.sigmoid(block_diag_linear(xc, w_x) + b_x)
    log_a = -LRU_C * r * jax.nn.softplus(-lam.astype(jnp.float32))
    a = jnp.exp(log_a)
    mult = jnp.sqrt(-jnp.expm1(2.0 * log_a))
    mult = jnp.where((jnp.arange(s) == 0)[None, :, None], 1.0, mult)
    u = mult * (i * xc).astype(jnp.float32)

    def combine(left, right):
        a_l, b_l = left
        a_r, b_r = right
        return a_l * a_r, a_r * b_l + b_r

    _, h = lax.associative_scan(combine, (a, u), axis=1)
    return h.astype(x.dtype)


def memory_attention(q, mem_k, mem_v):
    b, s, _ = q.shape
    q = q.reshape(b, s, MEM_HEADS, MEM_HEAD_DIM)
    sc = jnp.einsum('bshd,bmhd->bhsm', q, mem_k).astype(jnp.float32) * (MEM_HEAD_DIM ** -0.5)
    p = jax.nn.softmax(sc, axis=-1).astype(mem_v.dtype)
    return jnp.einsum('bhsm,bmhd->bshd', p, mem_v).reshape(b, s, MEM_WIDTH)


def hybrid_layer(x, mem, layer_idx, norm_g, w_in, lam_vecs, subln_g, pool_w, pool_scale,
                 conv_w, conv_b, lru_wa, lru_ba, lru_wx, lru_bx, lru_lambda,
                 mem_norm_g, w_mem_kv, w_branch, w_out):
    b, s, _ = x.shape
    h = rms_norm(x, norm_g)
    proj = h @ w_in
    q, k, v, x_pool, x_lru, q_mem, gate_in, merge_in = jnp.split(proj, SPLIT_POINTS, axis=-1)
    lambda_init = 0.8 - 0.6 * math.exp(-0.3 * layer_idx)
    y_a = diff_attention(q, k, v, lam_vecs, subln_g, lambda_init)
    y_b = multiscale_pool(x_pool, pool_w, pool_scale)
    y_c = rg_lru_branch(x_lru, conv_w, conv_b, lru_wa, lru_ba, lru_wx, lru_bx, lru_lambda)
    mkv = rms_norm(mem, mem_norm_g) @ w_mem_kv
    mk, mv = jnp.split(mkv, 2, axis=-1)
    mk = mk.reshape(b, MEM_LEN, MEM_HEADS, MEM_HEAD_DIM)
    mv = mv.reshape(b, MEM_LEN, MEM_HEADS, MEM_HEAD_DIM)
    y_m = memory_attention(q_mem, mk, mv)
    branches = jnp.concatenate([y_a, y_b, y_c, y_m], axis=-1) * jax.nn.silu(gate_in)
    merge_gates = jax.nn.sigmoid(merge_in).reshape(b, s, N_BRANCH, D_MODEL)
    merged = jnp.zeros_like(x)
    for bi in range(N_BRANCH):
        st, en = BRANCH_OFFSETS[bi], BRANCH_OFFSETS[bi + 1]
        merged = merged + merge_gates[:, :, bi] * (branches[..., st:en] @ w_branch[st:en])
    return x + merged @ w_out


def setup_inputs(seed: int = 0) -> dict:
    key = jax.random.key(seed)
    ks = jax.random.split(key, 24)
    f32 = jnp.float32
    nrm = lambda k, shape, sc: jax.random.normal(k, shape, f32) * sc
    x = jax.random.normal(ks[0], (BATCH, SEQ, D_MODEL), f32)
    mem = jax.random.normal(ks[1], (BATCH, MEM_LEN, D_MODEL), f32)
    norm_g = 1.0 + nrm(ks[2], (DEPTH, D_MODEL), 0.02)
    w_in = nrm(ks[3], (DEPTH, D_MODEL, N_IN), D_MODEL ** -0.5)
    lam_vecs = nrm(ks[4], (DEPTH, 4, DA_HEAD_DIM), 0.1)
    subln_g = 1.0 + nrm(ks[5], (DEPTH, 2 * DA_HEAD_DIM), 0.02)
    pool_w = nrm(ks[6], (DEPTH, len(POOL_WINDOWS), POOL_GROUP, POOL_GROUP), POOL_GROUP ** -0.5)
    pool_scale = 1.0 + nrm(ks[7], (DEPTH, POOL_WIDTH), 0.02)
    conv_w = nrm(ks[8], (DEPTH, CONV_WIDTH, LRU_WIDTH), CONV_WIDTH ** -0.5)
    conv_b = nrm(ks[9], (DEPTH, LRU_WIDTH), 0.01)
    lru_wa = nrm(ks[10], (DEPTH, LRU_BLOCKS, LRU_BLOCK, LRU_BLOCK), LRU_BLOCK ** -0.5)
    lru_ba = nrm(ks[11], (DEPTH, LRU_WIDTH), 0.01)
    lru_wx = nrm(ks[12], (DEPTH, LRU_BLOCKS, LRU_BLOCK, LRU_BLOCK), LRU_BLOCK ** -0.5)
    lru_bx = nrm(ks[13], (DEPTH, LRU_WIDTH), 0.01)
    a_pow_c = jax.random.uniform(ks[14], (DEPTH, LRU_WIDTH), f32, 0.9, 0.999)
    a0 = a_pow_c ** (1.0 / LRU_C)
    lru_lambda = jnp.log(a0) - jnp.log1p(-a0)
    mem_norm_g = 1.0 + nrm(ks[15], (DEPTH, D_MODEL), 0.02)
    w_mem_kv = nrm(ks[16], (DEPTH, D_MODEL, 2 * MEM_WIDTH), D_MODEL ** -0.5)
    bkeys = jax.random.split(ks[17], N_BRANCH)
    w_branch = jnp.concatenate([nrm(bkeys[i], (DEPTH, BRANCH_SIZES[i], D_MODEL), BRANCH_SIZES[i] ** -0.5)
                                for i in range(N_BRANCH)], axis=1)
    w_out = nrm(ks[18], (DEPTH, D_MODEL, D_MODEL), D_MODEL ** -0.5)
    final_g = 1.0 + nrm(ks[19], (D_MODEL,), 0.02)
    return {"x": x, "mem": mem, "norm_g": norm_g, "w_in": w_in, "lam_vecs": lam_vecs,
            "subln_g": subln_g, "pool_w": pool_w, "pool_scale": pool_scale,
            "conv_w": conv_w, "conv_b": conv_b, "lru_wa": lru_wa, "lru_ba": lru_ba,
            "lru_wx": lru_wx, "lru_bx": lru_bx, "lru_lambda": lru_lambda,
            "mem_norm_g": mem_norm_g, "w_mem_kv": w_mem_kv, "w_branch": w_branch,
            "w_out": w_out, "final_g": final_g}


def reference(x, mem, norm_g, w_in, lam_vecs, subln_g, pool_w, pool_scale, conv_w, conv_b,
              lru_wa, lru_ba, lru_wx, lru_bx, lru_lambda, mem_norm_g, w_mem_kv, w_branch,
              w_out, final_g):
    for l in range(DEPTH):
        x = hybrid_layer(x, mem, l, norm_g[l], w_in[l], lam_vecs[l], subln_g[l], pool_w[l],
                         pool_scale[l], conv_w[l], conv_b[l], lru_wa[l], lru_ba[l], lru_wx[l],
                         lru_bx[l], lru_lambda[l], mem_norm_g[l], w_mem_kv[l], w_branch[l], w_out[l])
    return rms_norm(x, final_g)
```

```cpp
#include <hip/hip_runtime.h>
#include <hip/hip_cooperative_groups.h>
#include <cstdio>
#include <cstdint>
namespace pg8 {
#define PG8_LAS __attribute__((address_space(3)))
typedef unsigned short bf16_t;
typedef short bf16x8 __attribute__((ext_vector_type(8)));
typedef float f32x4 __attribute__((ext_vector_type(4)));
typedef unsigned u32x4 __attribute__((ext_vector_type(4)));
constexpr int BM = 256, BK = 64, HALF = 128, HTB = HALF * BK * 2  , STAGE_BYTES = 8 * HTB, NXCD = 8, WGM = 8;

__host__ __device__ __forceinline__ int lds_byte(int r, int c) { const int st = (r >> 4) * 2 + (c >> 5), rr = r & 15, cc = c & 31, ob = rr * 64 + cc * 2; return st * 1024 + (ob ^ (((ob >> 9) & 1) << 5)); }
__host__ __device__ __forceinline__ void stage_rc(int b, int& R, int& C) { const int st = b / 1024, sb = b % 1024, swz = sb ^ (((sb >> 9) & 1) << 5); R = (st >> 1) * 16 + swz / 64; C = (st & 1) * 32 + (swz % 64) / 2; }
__host__ __device__ __forceinline__ int perm32(int rho) { const int n = rho >> 4, i = rho & 15; return 8 * (i >> 2) + 4 * n + (i & 3); }

struct Unit { int pm, pn, pg; };
struct Gemm { const bf16_t* A; const bf16_t* Bt; int M, N, K, lda, ldb, ng; size_t gA, gB; };

struct StaticOrder {
    int nM, nN, nwg, G, c, per;
    __host__ __device__ void init(int M, int N, int G_, int c_, int ng = 1) { nM = M / BM; nN = N / BM; per = nM * nN; nwg = per * ng; G = G_; c = c_; }
    __host__ __device__ bool next(int i, Unit& u) const {
        const long L = (long)i * G + c; if (L >= nwg) return false;
        int wgid = (int)L; { const int q = nwg / NXCD, r = nwg % NXCD, xcd = wgid % NXCD, off = wgid / NXCD; wgid = (xcd < r ? xcd * (q + 1) : r * (q + 1) + (xcd - r) * q) + off; }
        u.pg = wgid / per; wgid -= u.pg * per;
        const int nig = WGM * nN, gid = wgid / nig, fm = gid * WGM, gsz = (nM - fm) < WGM ? (nM - fm) : WGM;
        u.pm = fm + ((wgid % nig) % gsz); u.pn = (wgid % nig) / gsz; return true;
    }
    __device__ __forceinline__ void a_ready(const Unit&) const {}
    __device__ __forceinline__ void done(const Unit&) const {}
};

__device__ __forceinline__ unsigned cvt_pk_bf16(float lo, float hi) { unsigned r; asm volatile("v_cvt_pk_bf16_f32 %0, %1, %2" : "=v"(r) : "v"(lo), "v"(hi)); return r; }
typedef float f32x2 __attribute__((ext_vector_type(2)));
__device__ __forceinline__ f32x2 gelu_pk(f32x2 v) {
    const f32x2 av = __builtin_elementwise_abs(v), d = av * 0.2316418882f + 1.0f;
    f32x2 t; t.x = __builtin_amdgcn_rcpf(d.x); t.y = __builtin_amdgcn_rcpf(d.y);
    f32x2 q = t * 0.5307027145f + (-0.7265760135f); q = q * t + 0.7107068705f; q = q * t + (-0.142248368f); q = q * t + 0.127414796f; q = q * t;
    const f32x2 s = (v * v) * (-0.72134752044f);
    f32x2 e; e.x = __builtin_amdgcn_exp2f(s.x); e.y = __builtin_amdgcn_exp2f(s.y);
    const f32x2 m = v * (q * e), r = v - m;
    f32x2 o; o.x = v.x < 0.f ? m.x : r.x; o.y = v.y < 0.f ? m.y : r.y; return o;
}

template <class Epi, class Sched, bool ALIGN_EPI = false, bool SP2 = false>
__device__ __forceinline__ void gemm_phase(PG8_LAS unsigned char* lds, const Gemm g, const Sched& S, const Epi& E) {
    int tid = threadIdx.x; asm volatile("" : "+v"(tid));
    const int wid = __builtin_amdgcn_readfirstlane(tid >> 6), lane = tid & 63, wr = wid >> 2, wc = wid & 3, fr = lane & 15, fq = lane >> 4;
    int K = g.K; asm volatile("" : "+s"(K)); const int nt = K / BK;
    unsigned voffA[2], voffB[2];
#pragma unroll
    for (int i = 0; i < 2; ++i) { int R, C; stage_rc(tid * 16 + i * 8192, R, C); const int Rb = Epi::PERM ? ((R & ~31) + perm32(R & 31)) : R;
        voffA[i] = (unsigned)(R * g.lda + C) * 2u; voffB[i] = (unsigned)(Rb * g.ldb + C) * 2u; }
    const size_t kstep = (size_t)(BK * 2);
    const size_t hstepA = (size_t)HALF * g.lda * 2, hstepB = (size_t)HALF * g.ldb * 2;
    const size_t tstepA = 2 * hstepA, tstepB = 2 * hstepB;
    const unsigned ldsw = (unsigned)wid * 1024u;
    const int aoff = lds_byte(wr * 64 + fr, fq * 8), boff = lds_byte(wc * 32 + fr, fq * 8);
#define PG8_SA(b, h) (((b) * 2 + (h)) * HTB)
#define PG8_SB(b, h) ((4 + (b) * 2 + (h)) * HTB)
#define PG8_STAGE(bufoff, gbase, voff) do { _Pragma("unroll") for (int _i = 0; _i < 2; ++_i) \
        __builtin_amdgcn_global_load_lds((const unsigned*)((const char*)(gbase) + (voff)[_i]), (PG8_LAS unsigned*)(lds + (bufoff) + ldsw + _i * 8192), 16, 0, 0); } while (0)
#define PG8_LDA(dst, b, h) do { _Pragma("unroll") for (int m = 0; m < 4; ++m) _Pragma("unroll") for (int k = 0; k < 2; ++k) dst[m][k] = *(const PG8_LAS bf16x8*)(lds + PG8_SA(b, h) + aoff + m * 2048 + k * 1024); } while (0)
#define PG8_LDB(dst, b, h) do { _Pragma("unroll") for (int n = 0; n < 2; ++n) _Pragma("unroll") for (int k = 0; k < 2; ++k) dst[n][k] = *(const PG8_LAS bf16x8*)(lds + PG8_SB(b, h) + boff + n * 2048 + k * 1024); } while (0)
#define PG8_MMA(ai, bj, At, Bt) do { __builtin_amdgcn_s_setprio(1); _Pragma("unroll") for (int m = 0; m < 4; ++m) _Pragma("unroll") for (int n = 0; n < 2; ++n) _Pragma("unroll") for (int k = 0; k < 2; ++k) \
        acc[ai][bj][m][n] = __builtin_amdgcn_mfma_f32_16x16x32_bf16(Bt[n][k], At[m][k], acc[ai][bj][m][n], 0, 0, 0); __builtin_amdgcn_s_setprio(0); } while (0)
#define PG8_WAIT_V(n) asm volatile("s_waitcnt vmcnt(" #n ")" ::: "memory")
#define PG8_WAIT_L(n) asm volatile("s_waitcnt lgkmcnt(" #n ")" ::: "memory")
#define PG8_BAR __builtin_amdgcn_s_barrier()
#define PG8_SCHED __builtin_amdgcn_sched_barrier(0)
    Unit cur, nxt; int ui = 0;
    if (!S.next(0, cur)) return;
    f32x4 acc[2][2][4][2];
#pragma unroll
    for (int a = 0; a < 2; ++a)
#pragma unroll
        for (int b = 0; b < 2; ++b)
#pragma unroll
            for (int m = 0; m < 4; ++m)
#pragma unroll
                for (int n = 0; n < 2; ++n) acc[a][b][m][n] = (f32x4){0.f, 0.f, 0.f, 0.f};
    bf16x8 At[4][2], B0[2][2], B1[2][2];
    const char* cA = (const char*)g.A + (size_t)cur.pg * g.gA + (size_t)cur.pm * tstepA; const char* cB = (const char*)g.Bt + (size_t)cur.pg * g.gB + (size_t)cur.pn * tstepB;
    S.a_ready(cur);
    if constexpr (SP2) {
        PG8_STAGE(PG8_SB(0, 0), cB, voffB); PG8_STAGE(PG8_SB(0, 1), cB + hstepB, voffB); PG8_STAGE(PG8_SA(0, 0), cA, voffA); PG8_STAGE(PG8_SA(0, 1), cA + hstepA, voffA);
        if (wr == 1) PG8_BAR;
        PG8_WAIT_V(2); PG8_BAR;
        PG8_STAGE(PG8_SB(1, 0), cB + kstep, voffB); PG8_STAGE(PG8_SA(1, 0), cA + kstep, voffA); PG8_STAGE(PG8_SB(1, 1), cB + hstepB + kstep, voffB);
        PG8_WAIT_V(6); PG8_BAR;
    } else {
        PG8_STAGE(PG8_SB(0, 0), cB, voffB); PG8_STAGE(PG8_SA(0, 0), cA, voffA); PG8_STAGE(PG8_SB(0, 1), cB + hstepB, voffB); PG8_STAGE(PG8_SA(0, 1), cA + hstepA, voffA);
        if (wr == 1) PG8_BAR;
        PG8_WAIT_V(4); PG8_BAR;
        PG8_STAGE(PG8_SB(1, 0), cB + kstep, voffB); PG8_STAGE(PG8_SA(1, 0), cA + kstep, voffA); PG8_STAGE(PG8_SB(1, 1), cB + hstepB + kstep, voffB);
        PG8_WAIT_V(6); PG8_BAR;
    }
    for (;;) {
        const bool has_next = S.next(ui + 1, nxt);
        const char* nA = has_next ? (const char*)g.A + (size_t)nxt.pg * g.gA + (size_t)nxt.pm * tstepA : cA; const char* nB = has_next ? (const char*)g.Bt + (size_t)nxt.pg * g.gB + (size_t)nxt.pn * tstepB : cB;
#pragma unroll 1
        for (int t = 0; t < nt; t += 2) {
            const bool last = (t == nt - 2);
            const char* a1 = cA + (size_t)(t + 1) * kstep;
            const char* a2 = last ? nA : cA + (size_t)(t + 2) * kstep; const char* b2 = last ? nB : cB + (size_t)(t + 2) * kstep;
            const char* a3 = a2 + kstep; const char* b3 = b2 + kstep;
            if (last && has_next) S.a_ready(nxt);
            if constexpr (SP2) {
            PG8_LDB(B0, 0, 0); PG8_LDB(B1, 0, 1); PG8_SCHED; PG8_LDA(At, 0, 0); PG8_STAGE(PG8_SA(1, 1), a1 + hstepA, voffA);
            PG8_WAIT_V(8); PG8_WAIT_L(0); PG8_BAR; PG8_MMA(0, 0, At, B0); PG8_MMA(0, 1, At, B1); PG8_BAR; PG8_SCHED;
            PG8_LDA(At, 0, 1); PG8_STAGE(PG8_SB(0, 0), b2, voffB); PG8_STAGE(PG8_SB(0, 1), b2 + hstepB, voffB); PG8_STAGE(PG8_SA(0, 0), a2, voffA);
            PG8_WAIT_V(8); PG8_WAIT_L(0); PG8_BAR; PG8_MMA(1, 0, At, B0); PG8_MMA(1, 1, At, B1); PG8_BAR; PG8_SCHED;
            PG8_LDB(B0, 1, 0); PG8_LDB(B1, 1, 1); PG8_SCHED; PG8_LDA(At, 1, 0); PG8_STAGE(PG8_SA(0, 1), a2 + hstepA, voffA);
            PG8_WAIT_V(8); PG8_WAIT_L(0); PG8_BAR; PG8_MMA(0, 0, At, B0); PG8_MMA(0, 1, At, B1); PG8_BAR; PG8_SCHED;
            PG8_LDA(At, 1, 1); PG8_STAGE(PG8_SB(1, 0), b3, voffB); PG8_STAGE(PG8_SB(1, 1), b3 + hstepB, voffB); PG8_STAGE(PG8_SA(1, 0), a3, voffA);
            PG8_WAIT_V(8); PG8_WAIT_L(0); PG8_BAR; PG8_MMA(1, 0, At, B0); PG8_MMA(1, 1, At, B1); PG8_BAR; PG8_SCHED;
            } else {
            PG8_LDB(B0, 0, 0); PG8_SCHED; PG8_LDA(At, 0, 0); PG8_STAGE(PG8_SA(1, 1), a1 + hstepA, voffA);
            PG8_WAIT_L(8); PG8_BAR; PG8_WAIT_L(0); PG8_MMA(0, 0, At, B0); PG8_BAR; PG8_SCHED;
            PG8_LDB(B1, 0, 1); PG8_STAGE(PG8_SB(0, 0), b2, voffB);
            PG8_BAR; PG8_WAIT_L(0); PG8_MMA(0, 1, At, B1); PG8_BAR;
            PG8_LDA(At, 0, 1); PG8_STAGE(PG8_SA(0, 0), a2, voffA);
            PG8_BAR; PG8_WAIT_L(0); PG8_MMA(1, 0, At, B0); PG8_BAR; PG8_SCHED;
            PG8_STAGE(PG8_SB(0, 1), b2 + hstepB, voffB);
            PG8_WAIT_V(6); PG8_BAR; PG8_MMA(1, 1, At, B1); PG8_BAR;
            PG8_LDB(B0, 1, 0); PG8_SCHED; PG8_LDA(At, 1, 0); PG8_STAGE(PG8_SA(0, 1), a2 + hstepA, voffA);
            PG8_WAIT_L(8); PG8_BAR; PG8_WAIT_L(0); PG8_MMA(0, 0, At, B0); PG8_BAR; PG8_SCHED;
            PG8_LDB(B1, 1, 1); PG8_STAGE(PG8_SB(1, 0), b3, voffB);
            PG8_BAR; PG8_WAIT_L(0); PG8_MMA(0, 1, At, B1); PG8_BAR;
            PG8_LDA(At, 1, 1); PG8_STAGE(PG8_SA(1, 0), a3, voffA);
            PG8_BAR; PG8_WAIT_L(0); PG8_MMA(1, 0, At, B0); PG8_BAR; PG8_SCHED;
            PG8_STAGE(PG8_SB(1, 1), b3 + hstepB, voffB);
            PG8_WAIT_V(6); PG8_BAR; PG8_MMA(1, 1, At, B1); PG8_BAR;
            }
        }
        if constexpr (ALIGN_EPI) { if (wr == 0) PG8_BAR; }
        if constexpr (!Epi::AFTER_DRAIN) { E(acc, cur, wr, wc, fr, fq); S.done(cur); }
        if (!has_next) break;
#pragma unroll
        for (int a = 0; a < 2; ++a)
#pragma unroll
            for (int b = 0; b < 2; ++b)
#pragma unroll
                for (int m = 0; m < 4; ++m)
#pragma unroll
                    for (int n = 0; n < 2; ++n) acc[a][b][m][n] = (f32x4){0.f, 0.f, 0.f, 0.f};
        cur = nxt; cA = nA; cB = nB; ++ui;
        if constexpr (ALIGN_EPI) { if (wr == 1) PG8_BAR; }
    }
    PG8_WAIT_V(0);
    if constexpr (!ALIGN_EPI) { if (wr == 0) PG8_BAR; }
    PG8_BAR;
    if constexpr (Epi::AFTER_DRAIN) { E.fused(acc, cur, wr, wc, fr, fq, lds, wid, lane); S.done(cur); }
#undef PG8_SA
#undef PG8_SB
#undef PG8_STAGE
#undef PG8_LDA
#undef PG8_LDB
#undef PG8_MMA
#undef PG8_WAIT_V
#undef PG8_WAIT_L
#undef PG8_BAR
#undef PG8_SCHED
}
}
namespace pg8 {
typedef unsigned u32x2 __attribute__((ext_vector_type(2)));
constexpr float QSCALE = 0.125f * 1.4426950408889634f;
__device__ __forceinline__ float sigm(float v) { return __builtin_amdgcn_rcpf(1.0f + __builtin_amdgcn_exp2f(-1.4426950408889634f * v)); }
__device__ __forceinline__ float bf2f(unsigned short b) { return __builtin_bit_cast(float, (unsigned)b << 16); }
__device__ __forceinline__ float bflo(unsigned w) { return __builtin_bit_cast(float, w << 16); }
__device__ __forceinline__ float bfhi(unsigned w) { return __builtin_bit_cast(float, w & 0xffff0000u); }

struct EpiBf16Act {
    static constexpr bool PERM = true, AFTER_DRAIN = false;
    bf16_t* O; int ldc; int kind;
    __device__ __forceinline__ void operator()(const f32x4 (&acc)[2][2][4][2], const Unit& u, int wr, int wc, int fr, int fq) const {
        int mode = 0; float sc = 1.f;
        if (kind == 1) { if (u.pn < 4) sc = QSCALE; else if (u.pn >= 36) mode = 2; else if (u.pn >= 22) mode = 1;   }
        const int row0 = u.pm * BM + wr * 64 + fr, col0 = u.pn * BM + wc * 32 + 8 * fq;
#pragma unroll
        for (int ai = 0; ai < 2; ++ai)
#pragma unroll
            for (int m = 0; m < 4; ++m) { bf16_t* rowp = O + (size_t)(row0 + ai * HALF + m * 16) * ldc + col0;
#pragma unroll
                for (int bj = 0; bj < 2; ++bj) { f32x4 v0 = acc[ai][bj][m][0] * sc, v1 = acc[ai][bj][m][1] * sc;
                    if (mode != 0) {
#pragma unroll
                        for (int j = 0; j < 4; ++j) { const float s0 = sigm(v0[j]), s1 = sigm(v1[j]); v0[j] = (mode == 1) ? v0[j] * s0 : s0; v1[j] = (mode == 1) ? v1[j] * s1 : s1; } }
                    u32x4 w; w.x = cvt_pk_bf16(v0[0], v0[1]); w.y = cvt_pk_bf16(v0[2], v0[3]); w.z = cvt_pk_bf16(v1[0], v1[1]); w.w = cvt_pk_bf16(v1[2], v1[3]);
                    *(u32x4*)(rowp + bj * HALF) = w; } }
    }
};
struct EpiResF32 {
    static constexpr bool PERM = false, AFTER_DRAIN = false;
    const float* base; float* out; int ldc;
    __device__ __forceinline__ void operator()(const f32x4 (&acc)[2][2][4][2], const Unit& u, int wr, int wc, int fr, int fq) const {
        const int col0 = u.pn * BM + wc * 32 + 4 * fq;
#pragma unroll
        for (int ai = 0; ai < 2; ++ai)
#pragma unroll
            for (int m = 0; m < 4; ++m) { const size_t off = (size_t)(u.pm * BM + ai * HALF + wr * 64 + m * 16 + fr) * ldc + col0;
#pragma unroll
                for (int bj = 0; bj < 2; ++bj)
#pragma unroll
                    for (int n = 0; n < 2; ++n) { const f32x4 b = *(const f32x4*)(base + off + bj * HALF + n * 16); *(f32x4*)(out + off + bj * HALF + n * 16) = b + acc[ai][bj][m][n]; } }
    }
};
struct EpiBranch {
    static constexpr bool PERM = false, AFTER_DRAIN = false;
    const bf16_t* gate; int ldg; float* m32; bf16_t* ob; int ldc; int mode;
    __device__ __forceinline__ void operator()(const f32x4 (&acc)[2][2][4][2], const Unit& u, int wr, int wc, int fr, int fq) const {
        const int col0 = u.pn * BM + wc * 32 + 4 * fq;
#pragma unroll
        for (int ai = 0; ai < 2; ++ai)
#pragma unroll
            for (int m = 0; m < 4; ++m) { const size_t row = (size_t)(u.pm * BM + ai * HALF + wr * 64 + m * 16 + fr);
#pragma unroll
                for (int bj = 0; bj < 2; ++bj)
#pragma unroll
                    for (int n = 0; n < 2; ++n) { const int c = col0 + bj * HALF + n * 16;
                        const u32x2 gw = *(const u32x2*)(gate + row * ldg + c);
                        f32x4 v = acc[ai][bj][m][n]; v[0] *= bflo(gw.x); v[1] *= bfhi(gw.x); v[2] *= bflo(gw.y); v[3] *= bfhi(gw.y);
                        float* mp = m32 + row * ldc + c;
                        if (mode > 0) v = v + *(const f32x4*)mp;
                        if (mode < 2) *(f32x4*)mp = v;
                        else { u32x2 w; w.x = cvt_pk_bf16(v[0], v[1]); w.y = cvt_pk_bf16(v[2], v[3]); *(u32x2*)(ob + row * ldc + c) = w; } } }
    }
};
struct EpiPool {
    static constexpr bool PERM = true, AFTER_DRAIN = false;
    bf16_t* BR; const float* scale; const bf16_t* PROJ;
    __device__ __forceinline__ void operator()(const f32x4 (&acc)[2][2][4][2], const Unit& u, int wr, int wc, int fr, int fq) const {
        const unsigned row0 = (unsigned)(u.pm * BM + wr * 64 + fr), ch0 = (unsigned)(u.pg * 256 + wc * 32 + 8 * fq);
        const char* gb = (const char*)PROJ; char* ob = (char*)BR;
#pragma unroll
        for (int bj = 0; bj < 2; ++bj) { const unsigned ch = ch0 + bj * HALF; const f32x4 s0 = *(const f32x4*)(scale + ch), s1 = *(const f32x4*)(scale + ch + 4);
#pragma unroll
            for (int ai = 0; ai < 2; ++ai)
#pragma unroll
                for (int m = 0; m < 4; ++m) { const unsigned row = row0 + ai * HALF + m * 16;
                    const u32x4 gw = *(const u32x4*)(gb + (size_t)(row * 34816u + (6656u + ch) * 2u));
                    f32x4 v0 = acc[ai][bj][m][0] * s0, v1 = acc[ai][bj][m][1] * s1;
                    u32x4 w; w.x = cvt_pk_bf16(v0[0] * bflo(gw.x), v0[1] * bfhi(gw.x)); w.y = cvt_pk_bf16(v0[2] * bflo(gw.y), v0[3] * bfhi(gw.y));
                    w.z = cvt_pk_bf16(v1[0] * bflo(gw.z), v1[1] * bfhi(gw.z)); w.w = cvt_pk_bf16(v1[2] * bflo(gw.w), v1[3] * bfhi(gw.w));
                    *(u32x4*)(ob + (size_t)(row * 7168u + (1024u + ch) * 2u)) = w;
                    asm volatile("" ::: "memory"); } }
    }
};
struct EpiLru {
    static constexpr bool PERM = false, AFTER_DRAIN = false;
    const bf16_t* XC; const float *ba, *bx, *lam; float *ABUF, *UBUF;
    __device__ __forceinline__ void operator()(const f32x4 (&acc)[2][2][4][2], const Unit& u, int wr, int wc, int fr, int fq) const {
        const char* xb = (const char*)XC; char* ab = (char*)ABUF; char* ub = (char*)UBUF;
#pragma unroll
        for (int n = 0; n < 2; ++n) { const unsigned ch = (unsigned)(u.pg * 128 + wc * 32 + n * 16 + 4 * fq);
            const f32x4 bav = *(const f32x4*)(ba + ch), bxv = *(const f32x4*)(bx + ch), sp = *(const f32x4*)(lam + ch);
#pragma unroll
            for (int ai = 0; ai < 2; ++ai)
#pragma unroll
                for (int m = 0; m < 4; ++m) { const unsigned row = (unsigned)(u.pm * BM + ai * HALF + wr * 64 + m * 16 + fr); const unsigned off = row * 1024u + ch;
                    const u32x2 xw = *(const u32x2*)(xb + (size_t)(off * 2u)); const float xc[4] = {bflo(xw.x), bfhi(xw.x), bflo(xw.y), bfhi(xw.y)};
                    const f32x4 rp = acc[ai][0][m][n] + bav, ip = acc[ai][1][m][n] + bxv; f32x4 av, uv;
#pragma unroll
                    for (int j = 0; j < 4; ++j) { const float r = sigm(rp[j]), ig = sigm(ip[j]); const float a = __builtin_amdgcn_exp2f(sp[j] * r);
                        float mult = __builtin_sqrtf((1.0f - a) * (1.0f + a)); if ((row & 8191u) == 0u) mult = 1.0f;
                        av[j] = a; uv[j] = mult * ig * xc[j]; }
                    *(f32x4*)(ab + (size_t)(off * 4u)) = av; *(f32x4*)(ub + (size_t)(off * 4u)) = uv;
                    asm volatile("" ::: "memory"); } }
    }
};
}
#include <hip/hip_bf16.h>
#include <cmath>
namespace attn_body {
using bf16=__hip_bfloat16;
using bf16x8=__attribute__((ext_vector_type(8)))short;
using s16x4=__attribute__((ext_vector_type(4)))short;
using f32x16=__attribute__((ext_vector_type(16)))float;
using u32x4=__attribute__((ext_vector_type(4)))unsigned;
constexpr int BATCH=2,NHEAD=16,SEQ=8192,D=64,DM=NHEAD*D,QP=17408,OP=2048;
constexpr int NW=8,QBLK=32,QB=QBLK*NW,KVBLK=64,NQB=SEQ/QB;
constexpr int ATTN_PITCH=DM, ATTN_UNIT_ROWS=QB;
__device__ __forceinline__ int crow(int r,int hi){return (r&3)+8*(r>>2)+4*hi;}
#define SBAR() __builtin_amdgcn_sched_barrier(0)
__device__ __forceinline__ void cmask(f32x16&p0,f32x16&p1,int jb,int qrel,int hi){
  const float NEG=-INFINITY; int kb=64*jb+4*hi;
  #pragma unroll
  for(int r=0;r<16;++r){int kv=kb+(r&3)+8*(r>>2); if(kv>qrel)p0[r]=NEG; if(kv+32>qrel)p1[r]=NEG;}
}

constexpr int NSLOT=3, SLOTB=8192;
constexpr int LDS_K=0, LDS_V=NSLOT*SLOTB, LDS_WS=2*NSLOT*SLOTB, LDS_OST=LDS_WS+NW*64*4, LDS_BYTES=LDS_OST+NW*4096;
constexpr float C2=0.125f*1.4426950408889634f;
__device__ __forceinline__ void glds16(const void*gsrc,unsigned lds_dst){unsigned keep;
  asm volatile("s_mov_b32 %0, m0\n\ts_mov_b32 m0, %2\n\ts_nop 0\n\tglobal_load_lds_dwordx4 %1, off\n\ts_mov_b32 m0, %0":"=&s"(keep):"v"(gsrc),"s"(lds_dst):"memory");}
__device__ __forceinline__ float max3f(float a,float b,float c){float r;asm("v_max3_f32 %0, %1, %2, %3":"=v"(r):"v"(a),"v"(b),"v"(c));return r;}
__device__ __forceinline__ float max2f(float a,float b){float r;asm("v_max_f32_e32 %0, %1, %2":"=v"(r):"v"(a),"v"(b));return r;}
__device__ __forceinline__ float fadd_s(float a,float b){float r;asm("v_add_f32_e32 %0, %1, %2":"=v"(r):"v"(a),"v"(b));return r;}
__device__ __forceinline__ float fsub_s(float a,float b){float r;asm("v_sub_f32_e32 %0, %1, %2":"=v"(r):"v"(a),"v"(b));return r;}
typedef float f32x2_t __attribute__((ext_vector_type(2))); typedef __bf16 bf16x2_t __attribute__((ext_vector_type(2)));
__device__ __forceinline__ unsigned cvtpk_s(float lo,float hi){f32x2_t v={lo,hi};bf16x2_t b=__builtin_convertvector(v,bf16x2_t);return __builtin_bit_cast(unsigned,b);}
__device__ __forceinline__ void glds16s(const void*sbase,unsigned voff,unsigned lds_dst){unsigned keep;
  asm volatile("s_mov_b32 %0, m0\n\ts_mov_b32 m0, %3\n\ts_nop 0\n\tglobal_load_lds_dwordx4 %1, %2\n\ts_mov_b32 m0, %0":"=&s"(keep):"v"(voff),"s"(sbase),"s"(lds_dst):"memory");}
#define WAIT_BAR(N) asm volatile("s_waitcnt vmcnt(" #N ") lgkmcnt(0)\n\ts_barrier":::"memory")

__device__ __forceinline__ void qkt(f32x16&p0,f32x16&p1,const char*Kslot,const bf16x8*qr,const f32x16&negm,int r32,int hi){
  const char*kb=Kslot+hi*1024+r32*16;
  #pragma unroll
  for(int d0=0;d0<4;++d0){
    const bf16x8 b0=*reinterpret_cast<const bf16x8*>(kb+d0*2048);
    const bf16x8 b1=*reinterpret_cast<const bf16x8*>(kb+d0*2048+512);
    if(d0==0){p0=__builtin_amdgcn_mfma_f32_32x32x16_bf16(b0,qr[0],negm,0,0,0);p1=__builtin_amdgcn_mfma_f32_32x32x16_bf16(b1,qr[0],negm,0,0,0);}
    else{p0=__builtin_amdgcn_mfma_f32_32x32x16_bf16(b0,qr[d0],p0,0,0,0);p1=__builtin_amdgcn_mfma_f32_32x32x16_bf16(b1,qr[d0],p1,0,0,0);}}
}
typedef __attribute__((address_space(3))) const char* lds_cptr;
typedef short v4i16_t __attribute__((ext_vector_type(4)));
__device__ __forceinline__ void kload8(bf16x8*kf,lds_cptr kp){
  kf[0]=*(const __attribute__((address_space(3))) bf16x8*)(kp);      kf[1]=*(const __attribute__((address_space(3))) bf16x8*)(kp+512);
  kf[2]=*(const __attribute__((address_space(3))) bf16x8*)(kp+2048); kf[3]=*(const __attribute__((address_space(3))) bf16x8*)(kp+2560);
  kf[4]=*(const __attribute__((address_space(3))) bf16x8*)(kp+4096); kf[5]=*(const __attribute__((address_space(3))) bf16x8*)(kp+4608);
  kf[6]=*(const __attribute__((address_space(3))) bf16x8*)(kp+6144); kf[7]=*(const __attribute__((address_space(3))) bf16x8*)(kp+6656);
}
__device__ __forceinline__ void kload2(bf16x8*kf,lds_cptr kp,int j){ kf[2*j]=*(const __attribute__((address_space(3))) bf16x8*)(kp+j*2048); kf[2*j+1]=*(const __attribute__((address_space(3))) bf16x8*)(kp+j*2048+512); }
__device__ __forceinline__ s16x4 vtr(lds_cptr p){ return __builtin_bit_cast(s16x4,__builtin_amdgcn_ds_read_tr16_b64_v4i16((__attribute__((address_space(3))) v4i16_t*)p)); }
__device__ __forceinline__ float rowmax(const f32x16&p0,const f32x16&p1){
  float a=max3f(p0[0],p0[1],p1[0]),b=max3f(p0[2],p0[3],p1[1]);a=max3f(a,p1[2],p1[3]);
  #pragma unroll
  for(int r=4;r<16;r+=4){a=max3f(a,p0[r],p0[r+1]);b=max3f(b,p0[r+2],p0[r+3]);a=max3f(a,p1[r],p1[r+1]);b=max3f(b,p1[r+2],p1[r+3]);}
  const float m=max2f(a,b);
  auto rr=__builtin_amdgcn_permlane32_swap(__float_as_uint(m),__float_as_uint(m),false,false);
  return max2f(__uint_as_float(rr[0]),__uint_as_float(rr[1]));
}
__device__ __forceinline__ void pv(f32x16*o,int vb,bf16x8 pa0,bf16x8 pa1,bf16x8 pa2,bf16x8 pa3){
  #pragma unroll
  for(int d0=0;d0<2;++d0){s16x4 lo[4],hi[4];
    #pragma unroll
    for(int ks=0;ks<4;++ks){
      asm volatile("ds_read_b64_tr_b16 %0,%1 offset:%c2":"=&v"(lo[ks]):"v"(vb),"i"(d0*4096+ks*1024):"memory");
      asm volatile("ds_read_b64_tr_b16 %0,%1 offset:%c2":"=&v"(hi[ks]):"v"(vb),"i"(d0*4096+ks*1024+512):"memory");}
    asm volatile("s_waitcnt lgkmcnt(0)":::"memory");SBAR();
    #define PK(k) (bf16x8){lo[k][0],lo[k][1],lo[k][2],lo[k][3],hi[k][0],hi[k][1],hi[k][2],hi[k][3]}
    o[d0]=__builtin_amdgcn_mfma_f32_32x32x16_bf16(pa0,PK(0),o[d0],0,0,0);
    o[d0]=__builtin_amdgcn_mfma_f32_32x32x16_bf16(pa1,PK(1),o[d0],0,0,0);
    o[d0]=__builtin_amdgcn_mfma_f32_32x32x16_bf16(pa2,PK(2),o[d0],0,0,0);
    o[d0]=__builtin_amdgcn_mfma_f32_32x32x16_bf16(pa3,PK(3),o[d0],0,0,0);
    #undef PK
  }
}

#ifndef ATTN_STORE16
#define ATTN_STORE16(p,v) (*(u32x4*)(p)=(v))
#endif
template<int THRL> __device__ __forceinline__ void attn_unit(int b,int h,int vcol,int ocol,int qb,const bf16*Q,const bf16*__restrict__ K,const bf16*__restrict__ V,bf16*O,char*shm,const int tid){
  const int lane=tid&63,r32=lane&31,hi=lane>>5; const int wid=__builtin_amdgcn_readfirstlane(tid>>6);
  const long rowbase=(long)b*SEQ; const int q0=qb*QB;
  const bf16*Qw=Q+(rowbase+q0+wid*QBLK)*QP+h*D;
  const bf16*Kh=K+rowbase*QP+h*D,*Vh=V+rowbase*QP+vcol;
  const unsigned lds0=(unsigned)(uintptr_t)shm;
  float*wsf=(float*)(shm+LDS_WS)+wid*64;
  const unsigned koff=(unsigned)(lane*QP+wid*8)*2u;
  const unsigned voff=(unsigned)((16*(wid&3)+(lane>>2))*QP+(wid>>2)*32+(lane&3)*8)*2u;
  const unsigned kdst=lds0+LDS_K+wid*1024, vdst=lds0+LDS_V+wid*1024;
  #define DMA_K(t,slot) glds16s(Kh+(long)(t)*KVBLK*QP,koff,(unsigned)__builtin_amdgcn_readfirstlane(kdst+(slot)))
  #define DMA_V(t,slot) glds16s(Vh+(long)(t)*KVBLK*QP,voff,(unsigned)__builtin_amdgcn_readfirstlane(vdst+(slot)))
  const int vb0=(int)(lds0+LDS_V)+((lane>>4)&1)*32+(lane&3)*8+(4*hi+((lane&15)>>2))*64;
  const char*Kbase=shm+LDS_K; bf16x8 kf[8];
  const lds_cptr shm3=(lds_cptr)shm; const lds_cptr kp0=shm3+LDS_K+hi*1024+r32*16; const lds_cptr vp0=shm3+LDS_V+((lane>>4)&1)*32+(lane&3)*8+(4*hi+((lane&15)>>2))*64;
  const int NT=(q0+QB)/KVBLK;
  DMA_K(0,0);DMA_V(0,0);DMA_K(1,SLOTB);
  bf16x8 qr[4];
  #pragma unroll
  for(int d0=0;d0<4;++d0)qr[d0]=*reinterpret_cast<const bf16x8*>(&Qw[(long)r32*QP+d0*16+hi*8]);
  float mhat=0.f,l_reg=0.f;f32x16 o[2];o[0]=f32x16{};o[1]=f32x16{};
  const int qrel=wid*QBLK+r32;
  #define CMASK(P0,P1,t) do{int jb_=(t)-(NT-4); if(jb_>=0)cmask(P0,P1,jb_,qrel,hi);}while(0)
  bool resc=false;
  #define START(P0,P1) do{ const float rm=rowmax(P0,P1); resc=false; \
    { const float dl=rm; mhat=fadd_s(mhat,dl); \
      _Pragma("unroll") for(int r=0;r<16;++r){P0[r]=fsub_s(P0[r],dl);P1[r]=fsub_s(P1[r],dl);} \
      } \
    _Pragma("unroll") for(int r=0;r<16;++r)P0[r]=__builtin_amdgcn_exp2f(P0[r]); }while(0)
  #define RESC() do{ if(resc){ asm volatile("s_waitcnt lgkmcnt(0)":::"memory"); \
      _Pragma("unroll") for(int d_=0;d_<2;++d_) _Pragma("unroll") for(int r=0;r<16;++r)o[d_][r]*=wsf[crow(r,hi)]; } }while(0)
  f32x16 pA0,pA1,pB0,pB1;
  int sl_prev=0,sl_cur=0,sl_next=SLOTB;
  #define ROT() do{sl_prev=sl_cur;sl_cur=sl_next;sl_next=(sl_next==(NSLOT-1)*SLOTB)?0:sl_next+SLOTB;}while(0)
  DMA_K(2,2*SLOTB);
  WAIT_BAR(3);
  qkt(pA0,pA1,Kbase,qr,f32x16{},r32,hi);asm volatile("s_nop 15\n\ts_nop 7":"+v"(pA0),"+v"(pA1));CMASK(pA0,pA1,0);
  START(pA0,pA1);
  _Pragma("unroll") for(int r=0;r<16;++r)pA1[r]=__builtin_amdgcn_exp2f(pA1[r]);
  WAIT_BAR(0);
  DMA_K(3,0);DMA_V(1,SLOTB);
  ROT();
  kload8(kf,kp0+sl_cur);
  WAIT_BAR(2);
  s16x4 vlo[8],vhi[8]; u32x4 pw0,pw1,pw2,pw3;
  #define PKW(P,B) cvtpk_s(P[B],P[B+1])
  #define PAF(k) __builtin_bit_cast(bf16x8,pw##k)
  #define VFR(i) (bf16x8){vlo[i][0],vlo[i][1],vlo[i][2],vlo[i][3],vhi[i][0],vhi[i][1],vhi[i][2],vhi[i][3]}
  #define PIN(x) asm volatile("":"+v"(x))
  #define MX3(a,b,c) __builtin_fmaxf(__builtin_fmaxf((a),(b)),(c))
  #define GAPA(MF,A0,A1,A2,A3,W0,W1,PW) do{ MF; sacc+=A0; sacc+=A1; sacc+=A2; sacc+=A3; PIN(sacc); W0; W1; PIN(PW); SBAR(); }while(0)
  #define EX(v) __builtin_amdgcn_exp2f(v)
  #define GAPB(MF,X,B) do{ MF; X[B]=EX(X[B]); X[B+1]=EX(X[B+1]); X[B+2]=EX(X[B+2]); X[B+3]=EX(X[B+3]); PIN(X); SBAR(); }while(0)
  #define VRD(i) do{ vlo[i]=vtr(vp_+(((i)>>2)*4096+((i)&3)*1024)); vhi[i]=vtr(vp_+(((i)>>2)*4096+((i)&3)*1024+512)); }while(0)
  #define KRD(G,j) do{ if(G){ kload2(kf,kp0+sl_next,j); SBAR(); } }while(0)
  #define STEP(C0,C1,P0,P1,t,GK,GV,GL) do{ SBAR(); \
    const lds_cptr vp_=vp0+sl_prev; \
    VRD(0); SBAR(); float sacc=(P0[0]+P0[1]); \
    GAPA(C0=__builtin_amdgcn_mfma_f32_32x32x16_bf16(kf[0],qr[0],f32x16{},0,0,0), P0[2],P0[3],P0[4],P0[5],     pw0[0]=PKW(P0,0), pw0[1]=PKW(P0,2), pw0); \
    VRD(4); SBAR(); GAPA(C1=__builtin_amdgcn_mfma_f32_32x32x16_bf16(kf[1],qr[0],f32x16{},0,0,0), P0[6],P0[7],P0[8],P0[9],     pw0[2]=PKW(P0,4), pw0[3]=PKW(P0,6), pw0); \
    VRD(1); SBAR(); GAPA(C0=__builtin_amdgcn_mfma_f32_32x32x16_bf16(kf[2],qr[1],C0,0,0,0),   P0[10],P0[11],P0[12],P0[13], pw1[0]=PKW(P0,8), pw1[1]=PKW(P0,10), pw1); \
    VRD(5); SBAR(); GAPA(C1=__builtin_amdgcn_mfma_f32_32x32x16_bf16(kf[3],qr[1],C1,0,0,0),   P0[14],P0[15],P1[0],P1[1],   pw1[2]=PKW(P0,12),pw1[3]=PKW(P0,14), pw1); \
    VRD(2); SBAR(); GAPA(C0=__builtin_amdgcn_mfma_f32_32x32x16_bf16(kf[4],qr[2],C0,0,0,0),   P1[2],P1[3],P1[4],P1[5],     pw2[0]=PKW(P1,0), pw2[1]=PKW(P1,2), pw2); \
    VRD(6); SBAR(); GAPA(C1=__builtin_amdgcn_mfma_f32_32x32x16_bf16(kf[5],qr[2],C1,0,0,0),   P1[6],P1[7],P1[8],P1[9],     pw2[2]=PKW(P1,4), pw2[3]=PKW(P1,6), pw2); \
    VRD(3); SBAR(); GAPA(C0=__builtin_amdgcn_mfma_f32_32x32x16_bf16(kf[6],qr[3],C0,0,0,0),   P1[10],P1[11],P1[12],P1[13], pw3[0]=PKW(P1,8), pw3[1]=PKW(P1,10), pw3); \
    VRD(7); SBAR(); GAPA(C1=__builtin_amdgcn_mfma_f32_32x32x16_bf16(kf[7],qr[3],C1,0,0,0),   P1[14],P1[15],0.f,0.f,       pw3[2]=PKW(P1,12),pw3[3]=PKW(P1,14), pw3); \
    l_reg+=sacc; \
    if(GK){DMA_K((t)+3,sl_cur);} if(GV){DMA_V((t)+1,sl_next);} \
    _Pragma("unroll") for(int r=0;r<16;++r){C0[r]-=mhat;C1[r]-=mhat;} \
    CMASK(C0,C1,t); \
    { float a=MX3(C0[0],C0[1],C1[0]),b=MX3(C0[2],C0[3],C1[1]); a=MX3(a,C1[2],C1[3]); \
      _Pragma("unroll") for(int r=4;r<16;r+=4){a=MX3(a,C0[r],C0[r+1]);b=MX3(b,C0[r+2],C0[r+3]);a=MX3(a,C1[r],C1[r+1]);b=MX3(b,C1[r+2],C1[r+3]);} \
      float rm=__builtin_fmaxf(a,b); { auto rr=__builtin_amdgcn_permlane32_swap(__float_as_uint(rm),__float_as_uint(rm),false,false); rm=__builtin_fmaxf(__uint_as_float(rr[0]),__uint_as_float(rr[1])); } \
      resc=false; \
      if(__builtin_expect(__any(rm>(float)THRL),0)){ const float dl=__builtin_fmaxf(rm,0.f); mhat+=dl; \
        _Pragma("unroll") for(int r=0;r<16;++r){C0[r]-=dl;C1[r]-=dl;} \
        const float f=__builtin_amdgcn_exp2f(-dl); l_reg*=f; if(hi==0)wsf[r32]=f; resc=true; } } \
    SBAR(); \
    GAPB(o[0]=__builtin_amdgcn_mfma_f32_32x32x16_bf16(PAF(0),VFR(0),o[0],0,0,0), C0,0); \
    GAPB(o[1]=__builtin_amdgcn_mfma_f32_32x32x16_bf16(PAF(0),VFR(4),o[1],0,0,0), C0,4); \
    KRD(GL,0); GAPB(o[0]=__builtin_amdgcn_mfma_f32_32x32x16_bf16(PAF(1),VFR(1),o[0],0,0,0), C0,8); \
    KRD(GL,1); GAPB(o[1]=__builtin_amdgcn_mfma_f32_32x32x16_bf16(PAF(1),VFR(5),o[1],0,0,0), C0,12); \
    KRD(GL,2); GAPB(o[0]=__builtin_amdgcn_mfma_f32_32x32x16_bf16(PAF(2),VFR(2),o[0],0,0,0), C1,0); \
    KRD(GL,3); GAPB(o[1]=__builtin_amdgcn_mfma_f32_32x32x16_bf16(PAF(2),VFR(6),o[1],0,0,0), C1,4); \
    GAPB(o[0]=__builtin_amdgcn_mfma_f32_32x32x16_bf16(PAF(3),VFR(3),o[0],0,0,0), C1,8); \
    GAPB(o[1]=__builtin_amdgcn_mfma_f32_32x32x16_bf16(PAF(3),VFR(7),o[1],0,0,0), C1,12); \
    }while(0)
  int t=1;
  #undef CMASK
  #define CMASK(P0,P1,t) do{}while(0)
  for(;t+5<NT;t+=2){
    STEP(pB0,pB1,pA0,pA1,t,true,true,true);     WAIT_BAR(2); RESC(); ROT();
    STEP(pA0,pA1,pB0,pB1,t+1,true,true,true);   WAIT_BAR(2); RESC(); ROT();
  }
  #undef CMASK
  #define CMASK(P0,P1,t) do{int jb_=(t)-(NT-4); if(jb_>=0)cmask(P0,P1,jb_,qrel,hi);}while(0)
  #define ENDW(tt) do{ if((tt)+3<NT){WAIT_BAR(2);} else if((tt)+2<NT){WAIT_BAR(1);} else {WAIT_BAR(0);} }while(0)
  for(;t+1<NT;t+=2){
    STEP(pB0,pB1,pA0,pA1,t,(t+3<NT),(t+1<NT),(t+1<NT));       ENDW(t);   RESC(); ROT();
    STEP(pA0,pA1,pB0,pB1,t+1,(t+4<NT),(t+2<NT),(t+2<NT));     ENDW(t+1); RESC(); ROT();
  }
  STEP(pB0,pB1,pA0,pA1,NT-1,false,false,false); RESC();
  { float sacc=pB0[0]+pB0[1]; _Pragma("unroll") for(int r=2;r<16;++r)sacc+=pB0[r]; _Pragma("unroll") for(int r=0;r<16;++r)sacc+=pB1[r]; l_reg+=sacc;
    pw0=(u32x4){PKW(pB0,0),PKW(pB0,2),PKW(pB0,4),PKW(pB0,6)};pw1=(u32x4){PKW(pB0,8),PKW(pB0,10),PKW(pB0,12),PKW(pB0,14)};pw2=(u32x4){PKW(pB1,0),PKW(pB1,2),PKW(pB1,4),PKW(pB1,6)};pw3=(u32x4){PKW(pB1,8),PKW(pB1,10),PKW(pB1,12),PKW(pB1,14)};
    SBAR(); pv(o,vb0+sl_cur,PAF(0),PAF(1),PAF(2),PAF(3)); }
  #undef PKW
  #undef PAF
  #undef VFR
  #undef PIN
  #undef MX3
  #undef GAPA
  #undef GAPB
  #undef EX
  #undef VRD
  #undef KRD
  #undef STEP
  #undef ENDW
  {auto rr=__builtin_amdgcn_permlane32_swap(__float_as_uint(l_reg),__float_as_uint(l_reg),false,false);l_reg=__uint_as_float(rr[0])+__uint_as_float(rr[1]);}
  if(hi==0)wsf[32+r32]=l_reg;asm volatile("s_waitcnt lgkmcnt(0)":::"memory");
  float rli[16];
  #pragma unroll
  for(int r=0;r<16;++r)rli[r]=__builtin_amdgcn_rcpf(wsf[32+crow(r,hi)]);
  bf16*Ow=O+(rowbase+q0+wid*QBLK)*OP+ocol;
  { bf16*stg=(bf16*)(shm+LDS_OST)+wid*2048;
    #pragma unroll
    for(int r=0;r<16;++r){const int orow=crow(r,hi);
      #pragma unroll
      for(int d0=0;d0<2;++d0)stg[orow*64+d0*32+r32]=__float2bfloat16(o[d0][r]*rli[r]);}
    asm volatile("s_waitcnt lgkmcnt(0)":::"memory");
    #pragma unroll
    for(int i=0;i<4;++i){const int row=i*8+(lane>>3),ch=lane&7; const u32x4 v=*(const u32x4*)(stg+row*64+ch*8); ATTN_STORE16(Ow+(long)row*OP+ch*8,v);} }
  asm volatile("s_waitcnt lgkmcnt(0)\n\ts_barrier":::"memory");
  #undef DMA_K
  #undef DMA_V
  #undef CMASK
  #undef START
  #undef RESC
  #undef ROT
}
constexpr int ATTN_LDS_BYTES=LDS_BYTES;
struct AttnTensors { const bf16* Q; const bf16* K; const bf16* V; bf16* O; };
template<int THRL=8> __device__ __forceinline__ void attn_phase(char*lds,const AttnTensors&T,int vcu,int G){
  int tid=threadIdx.x; asm volatile("":"+v"(tid));
  const bool bal=(G==256); const int s=vcu&7;
  for(int i=0;;++i){ int bh,e,qb;
    if(bal){ if(i>=8)break; const int k=i&3; bh=vcu>>3; e=i>>2; qb=(k==0)?s:(k==1)?15-s:(k==2)?16+s:31-s; }
    else{ const int u=vcu+i*G; if(u>=2048)break; qb=31-(u&31); e=(u>>5)&1; bh=u>>6; }
    const int b=bh>>4,hc=bh&15,hd=hc>>1,c=hc&1;
    attn_unit<THRL>(b,hc,hd*128+e*64,c*1024+hd*128+e*64,qb,T.Q,T.K,T.V,T.O,lds,tid); }
}
#undef SBAR
#undef WAIT_BAR
}
namespace cg = cooperative_groups;
constexpr int NWAVES = 8;
constexpr int BATCH = 2, SEQ = 8192, DMODEL = 2048, T = BATCH * SEQ, NIN = 17408, BRW = 3584;
constexpr float EPS = 1e-6f;
constexpr size_t MiB = 1u << 20;
constexpr size_t WS_PROJ = 0;
constexpr size_t WS_WIN  = 544 * MiB;
constexpr size_t WS_WBR  = 612 * MiB;
constexpr size_t WS_WOUT = 626 * MiB;
constexpr size_t WS_WKV  = 634 * MiB;
constexpr size_t WS_PW   = 638 * MiB;
constexpr size_t WS_LW   = 638 * MiB + 512 * 1024;
constexpr size_t WS_MEMN = 639 * MiB;
constexpr size_t WS_MK   = 641 * MiB;
constexpr size_t WS_VT   = 641 * MiB + 512 * 1024;
constexpr size_t WS_AGG  = 642 * MiB;
constexpr size_t WS_XN   = 644 * MiB;
constexpr size_t WS_X1   = 708 * MiB;
constexpr size_t WS_BR   = 836 * MiB;
constexpr size_t WS_DP   = 948 * MiB;
constexpr size_t WS_XC   = 980 * MiB;
constexpr size_t WS_END  = 1012 * MiB;
constexpr int LDS_BYTES = 147456;
#ifndef MK_MULTI
#define MK_MULTI 0
#endif
#define PH(k) if constexpr (((PHM) >> (k)) & 1)
#define GSYNC() do { if constexpr (((PHM) & ((PHM) - 1)) != 0) grid.sync(); } while (0)

#define LAS __attribute__((address_space(3)))
typedef unsigned short bf16;
typedef unsigned v4u __attribute__((ext_vector_type(4)));
typedef unsigned v2u __attribute__((ext_vector_type(2)));
typedef float f32x4 __attribute__((ext_vector_type(4)));
typedef short bf16x8 __attribute__((ext_vector_type(8)));
typedef short s16x4 __attribute__((ext_vector_type(4)));
typedef float f32x16 __attribute__((ext_vector_type(16)));
#define LDS_WAIT() asm volatile("s_waitcnt lgkmcnt(0)" ::: "memory")
__device__ __forceinline__ unsigned f2bf(float f) { unsigned u = __builtin_bit_cast(unsigned, f); return (u + 0x7fffu + ((u >> 16) & 1u)) >> 16; }
__device__ __forceinline__ unsigned pk2(float lo, float hi) { return f2bf(lo) | (f2bf(hi) << 16); }
__device__ __forceinline__ float blo(unsigned w) { return __builtin_bit_cast(float, w << 16); }
__device__ __forceinline__ float bhi(unsigned w) { return __builtin_bit_cast(float, w & 0xffff0000u); }
__device__ __forceinline__ float shx(float v, int o, int lane) { return __builtin_bit_cast(float, __builtin_amdgcn_ds_bpermute((lane ^ o) << 2, __builtin_bit_cast(int, v))); }
__device__ __forceinline__ float wave_sum(float v, int lane) {
#pragma unroll
    for (int o = 1; o < 64; o <<= 1) v += shx(v, o, lane);
    return v;
}
__device__ __forceinline__ void p0_transpose_item(const float* W, int K, int N, bf16* WT, int row_off, LAS float* scr, int item, int lane) {
    const int nblk = N / 32, kb = item / nblk, nb = item % nblk, k0 = 64 * kb, n0 = 32 * nb;
#pragma unroll 8
    for (int i = 0; i < 32; ++i) { const int kk = 2 * i + (lane >> 5); scr[kk * 33 + (lane & 31)] = W[(size_t)(k0 + kk) * N + n0 + (lane & 31)]; }
    LDS_WAIT(); asm volatile("" ::: "memory");
    const int c = lane & 7;
#pragma unroll
    for (int j = 0; j < 4; ++j) { const int n = (lane >> 3) + 8 * j; const LAS float* s = scr + (8 * c) * 33 + n;
        v4u o; o.x = pk2(s[0 * 33], s[1 * 33]); o.y = pk2(s[2 * 33], s[3 * 33]); o.z = pk2(s[4 * 33], s[5 * 33]); o.w = pk2(s[6 * 33], s[7 * 33]);
        *(v4u*)(WT + (size_t)(row_off + n0 + n) * K + k0 + 8 * c) = o; }
    LDS_WAIT(); asm volatile("" ::: "memory");
}
template <bool OUTF> __device__ __forceinline__ void rms_row(const float* xrow, const float* g, void* orow, int lane) {
    const f32x4* xr = (const f32x4*)xrow + lane; f32x4 v[8]; float s = 0.f;
#pragma unroll
    for (int j = 0; j < 8; ++j) { v[j] = xr[64 * j]; s += (v[j].x * v[j].x + v[j].y * v[j].y) + (v[j].z * v[j].z + v[j].w * v[j].w); }
    const float rstd = 1.0f / sqrtf(wave_sum(s, lane) * (1.0f / 2048.0f) + EPS);
#pragma unroll
    for (int j = 0; j < 8; ++j) { const f32x4 gv = ((const f32x4*)g)[lane + 64 * j]; const f32x4 o = v[j] * rstd * gv;
        if (OUTF) ((f32x4*)orow)[lane + 64 * j] = o;
        else { v2u w; w.x = pk2(o.x, o.y); w.y = pk2(o.z, o.w); ((v2u*)orow)[lane + 64 * j] = w; } }
}

__device__ __forceinline__ void memattn_unit(const bf16* PROJ, const bf16* MK, const bf16* VT, bf16* BR, int b, int hm, int rb, int lane) {
    const int q = lane & 31, hi = lane >> 5;
    const size_t row = (size_t)b * SEQ + (size_t)rb * 32 + q;
    bf16x8 qf[8];
#pragma unroll
    for (int d0 = 0; d0 < 8; ++d0) qf[d0] = *(const bf16x8*)(PROJ + row * NIN + 5120 + hm * 128 + d0 * 16 + hi * 8);
    const f32x16 zz = f32x16{};
    f32x16 sc[8];
#pragma unroll
    for (int kb = 0; kb < 8; ++kb) { sc[kb] = zz;
        const bf16* kp = MK + (size_t)(b * 256 + kb * 32 + q) * 512 + hm * 128 + hi * 8;
#pragma unroll
        for (int d0 = 0; d0 < 8; ++d0) { const bf16x8 kf = *(const bf16x8*)(kp + d0 * 16); sc[kb] = __builtin_amdgcn_mfma_f32_32x32x16_bf16(kf, qf[d0], sc[kb], 0, 0, 0); }
        __builtin_amdgcn_sched_barrier(0); }
    float mx = -INFINITY;
#pragma unroll
    for (int kb = 0; kb < 8; ++kb)
#pragma unroll
        for (int r = 0; r < 16; ++r) mx = fmaxf(mx, sc[kb][r]);
    mx = fmaxf(mx, shx(mx, 32, lane));
    const float cs = 0.08838834764831845f * 1.4426950408889634f; float l = 0.f;
#pragma unroll
    for (int kb = 0; kb < 8; ++kb)
#pragma unroll
        for (int r = 0; r < 16; ++r) { const float p = __builtin_amdgcn_exp2f((sc[kb][r] - mx) * cs); sc[kb][r] = p; l += p; }
    l += shx(l, 32, lane);
    const float inv = 1.0f / l;
    v4u pk[8][2];
#pragma unroll
    for (int kb = 0; kb < 8; ++kb)
#pragma unroll
        for (int s = 0; s < 2; ++s) {
            pk[kb][s].x = pk2(sc[kb][8 * s + 0] * inv, sc[kb][8 * s + 1] * inv); pk[kb][s].y = pk2(sc[kb][8 * s + 2] * inv, sc[kb][8 * s + 3] * inv);
            pk[kb][s].z = pk2(sc[kb][8 * s + 4] * inv, sc[kb][8 * s + 5] * inv); pk[kb][s].w = pk2(sc[kb][8 * s + 6] * inv, sc[kb][8 * s + 7] * inv); }
#pragma unroll
    for (int kb = 0; kb < 8; ++kb) asm volatile("" : "+v"(pk[kb][0]), "+v"(pk[kb][1]));
    f32x16 o[4]; o[0] = zz; o[1] = zz; o[2] = zz; o[3] = zz;
#pragma unroll
    for (int kb = 0; kb < 8; ++kb)
#pragma unroll
        for (int s = 0; s < 2; ++s) {
            const bf16x8 pb = __builtin_bit_cast(bf16x8, pk[kb][s]);
#pragma unroll
            for (int db = 0; db < 4; ++db) { const bf16* vp = VT + (size_t)(hm * 128 + db * 32 + q) * 512 + b * 256 + kb * 32 + 16 * s + 4 * hi;
                const s16x4 lo = *(const s16x4*)vp, hh = *(const s16x4*)(vp + 8);
                const bf16x8 va = (bf16x8){lo[0], lo[1], lo[2], lo[3], hh[0], hh[1], hh[2], hh[3]};
                o[db] = __builtin_amdgcn_mfma_f32_32x32x16_bf16(va, pb, o[db], 0, 0, 0); }
            __builtin_amdgcn_sched_barrier(0); }
#pragma unroll
    for (int db = 0; db < 4; ++db)
#pragma unroll
        for (int g4 = 0; g4 < 4; ++g4) { const int d = hm * 128 + db * 32 + g4 * 8 + 4 * hi;
            const v2u gw = *(const v2u*)(PROJ + row * NIN + 5632 + 3072 + d);
            v2u w; w.x = pk2(o[db][4 * g4 + 0] * blo(gw.x), o[db][4 * g4 + 1] * bhi(gw.x)); w.y = pk2(o[db][4 * g4 + 2] * blo(gw.y), o[db][4 * g4 + 3] * bhi(gw.y));
            *(v2u*)(BR + row * BRW + 3072 + d) = w; }
}

struct Args { const float* in[20]; float* out; unsigned char* ws; };
#define CAS __attribute__((address_space(4)))
__device__ __forceinline__ unsigned long long karg64(int byte_off) {
    const CAS char* p = (const CAS char*)__builtin_amdgcn_kernarg_segment_ptr(); asm volatile("" : "+s"(p));
    return *(const CAS unsigned long long*)(p + byte_off);
}
__device__ __forceinline__ const float* getp(int k) { return (const float*)(uintptr_t)karg64(8 * k); }
template <int PHM> __device__ __forceinline__ void layer_body(unsigned char* lds, LAS unsigned char* ldsl, cg::grid_group& grid, const int l) {
#define PHASE_IDS() int tid = threadIdx.x; asm volatile("" : "+v"(tid)); int G = gridDim.x, bx = blockIdx.x; asm volatile("" : "+s"(G), "+s"(bx)); \
    unsigned char* ws = (unsigned char*)(uintptr_t)karg64(168); float* outp = (float*)(uintptr_t)karg64(160); \
    const int vcu = (G % 8 == 0) ? (bx % 8) * (G / 8) + bx / 8 : bx, NGW = G * NWAVES, NGT = G * NWAVES * 64; \
    const int lane = tid & 63, wave = __builtin_amdgcn_readfirstlane(tid >> 6), gw = vcu * NWAVES + wave, gt = vcu * (NWAVES * 64) + tid; \
    bf16* PROJ = (bf16*)(ws + WS_PROJ); bf16* WIN = (bf16*)(ws + WS_WIN); bf16* WBR = (bf16*)(ws + WS_WBR); bf16* WOUT = (bf16*)(ws + WS_WOUT); bf16* WKV = (bf16*)(ws + WS_WKV); \
    bf16* PW = (bf16*)(ws + WS_PW); bf16* LW = (bf16*)(ws + WS_LW); bf16* MEMN = (bf16*)(ws + WS_MEMN); bf16* MK = (bf16*)(ws + WS_MK); bf16* VT = (bf16*)(ws + WS_VT); \
    float* AGGP = (float*)(ws + WS_AGG); float* AGGH = AGGP + 128 * 1024; float* SPB = AGGH + 128 * 1024; \
    bf16* XN = (bf16*)(ws + WS_XN); bf16* AO = XN; bf16* MB = XN; float* X1 = (float*)(ws + WS_X1); bf16* BR = (bf16*)(ws + WS_BR); bf16* DP = (bf16*)(ws + WS_DP); bf16* XC = (bf16*)(ws + WS_XC); \
    float* ABUF = outp; float* UBUF = outp + (size_t)T * 1024; float* M32 = outp; \
    (void)lane; (void)wave; (void)gw; (void)gt; (void)NGW; (void)NGT; (void)PROJ; (void)WIN; (void)WBR; (void)WOUT; (void)WKV; (void)PW; (void)LW; (void)MEMN; (void)MK; (void)VT; (void)AGGP; (void)AGGH; (void)SPB; \
    (void)XN; (void)AO; (void)MB; (void)X1; (void)BR; (void)DP; (void)XC; (void)ABUF; (void)UBUF; (void)M32
#define GETP(k) getp(k)

        const float lambda_init = (l == 0) ? 0.2f : 0.35550906759f;

        PH(0) { PHASE_IDS();
            LAS float* scr = (LAS float*)(ldsl + wave * 16384);
            const float* xin = (l == 0) ? GETP(0) : X1; const float* mem = GETP(1);
            const float* norm_g = GETP(2) + l * 2048; const float* w_in = GETP(3) + (size_t)l * 2048 * NIN; const float* pool_w = GETP(6) + (size_t)l * 4 * 65536;
            const float* lru_wa = GETP(10) + (size_t)l * 8 * 16384; const float* lru_wx = GETP(12) + (size_t)l * 8 * 16384; const float* lru_lam = GETP(14) + l * 1024;
            const float* mem_g = GETP(15) + l * 2048; const float* w_kv = GETP(16) + (size_t)l * 2048 * 1024; const float* w_br = GETP(17) + (size_t)l * BRW * 2048; const float* w_out = GETP(18) + (size_t)l * 2048 * 2048;
            constexpr int I_IN = 32 * 544, I_BR = 56 * 64, I_OUT = 32 * 64, I_KV = 32 * 32, I_PW = 4 * 32, I_LW = 8 * 8;
            constexpr int NITEMS = I_IN + I_BR + I_OUT + I_KV + I_PW + 2 * I_LW;
            for (int it = gw; it < NITEMS; it += NGW) {
                int r = it;
                if (r < I_IN) { p0_transpose_item(w_in, 2048, NIN, WIN, 0, scr, r, lane); continue; } r -= I_IN;
                if (r < I_BR) { p0_transpose_item(w_br, BRW, 2048, WBR, 0, scr, r, lane); continue; } r -= I_BR;
                if (r < I_OUT) { p0_transpose_item(w_out, 2048, 2048, WOUT, 0, scr, r, lane); continue; } r -= I_OUT;
                if (r < I_KV) { p0_transpose_item(w_kv, 2048, 1024, WKV, 0, scr, r, lane); continue; } r -= I_KV;
                if (r < I_PW) { const int g = r / 32; p0_transpose_item(pool_w + g * 65536, 256, 256, PW + g * 65536, 0, scr, r % 32, lane); continue; } r -= I_PW;
                if (r < I_LW) { const int g = r / 8; p0_transpose_item(lru_wa + g * 16384, 128, 128, LW + g * 32768, 0, scr, r % 8, lane); continue; } r -= I_LW;
                { const int g = r / 8; p0_transpose_item(lru_wx + g * 16384, 128, 128, LW + g * 32768, 128, scr, r % 8, lane); }
            }
            for (int m = gw; m < T; m += NGW) rms_row<false>(xin + (size_t)m * 2048, norm_g, XN + (size_t)m * 2048, lane);
            for (int m = gw; m < 512; m += NGW) rms_row<false>(mem + (size_t)m * 2048, mem_g, MEMN + (size_t)m * 2048, lane);
            if (gt < 1024) SPB[gt] = -8.0f * 1.4426950408889634f * log1pf(__expf(-lru_lam[gt]));
        }
        GSYNC();

        PH(1) { PHASE_IDS();
#pragma unroll 1
            for (int call = 0; call < 3; ++call) {
                const bf16* A = (call == 0) ? XN : (call == 1) ? MEMN : WKV + (size_t)512 * 2048; const bf16* B = (call == 0) ? WIN : (call == 1) ? WKV : MEMN;
                const int Mm = (call == 0) ? T : 512, Nn = (call == 0) ? NIN : 512;
                pg8::Gemm g{A, B, Mm, Nn, 2048, 2048, 2048, 1, 0, 0}; pg8::StaticOrder S; S.init(Mm, Nn, G, (call == 2) ? (bx + G / 2) % G : bx);
                pg8::EpiBf16Act E{(call == 0) ? PROJ : (call == 1) ? MK : VT, (call == 0) ? NIN : 512, (call == 0) ? 1 : 0};
                pg8::gemm_phase<pg8::EpiBf16Act, pg8::StaticOrder, true, true>(ldsl, g, S, E);
            }
        }
        GSYNC();

        PH(2) { PHASE_IDS(); const float* conv_w = GETP(8) + l * 4096; const float* conv_b = GETP(9) + l * 1024;
        for (int it = gt; it < T * 128; it += NGT) {
            const int row = it >> 7, ck = it & 127, t = row & (SEQ - 1), ch = ck * 8;
            {
                const int w = 2 << (ch >> 8); const int cnt = (t + 1 < w) ? t + 1 : w;
                const bf16* p = PROJ + (size_t)row * NIN + 3072 + ch; float s[8] = {0.f, 0.f, 0.f, 0.f, 0.f, 0.f, 0.f, 0.f}; float x0[8];
                for (int u = 0; u < cnt; ++u) { const v4u v = *(const v4u*)(p - (size_t)u * NIN);
                    const float f[8] = {blo(v.x), bhi(v.x), blo(v.y), bhi(v.y), blo(v.z), bhi(v.z), blo(v.w), bhi(v.w)};
#pragma unroll
                    for (int j = 0; j < 8; ++j) { s[j] += f[j]; if (u == 0) x0[j] = f[j]; } }
                const float ic = 1.0f / (float)cnt; v4u o;
                o.x = pk2(s[0] * ic - x0[0], s[1] * ic - x0[1]); o.y = pk2(s[2] * ic - x0[2], s[3] * ic - x0[3]); o.z = pk2(s[4] * ic - x0[4], s[5] * ic - x0[5]); o.w = pk2(s[6] * ic - x0[6], s[7] * ic - x0[7]);
                *(v4u*)(DP + (size_t)row * 1024 + ch) = o;
            }
            {
                const bf16* p = PROJ + (size_t)row * NIN + 4096 + ch; float s[8];
                { const f32x4 b0 = *(const f32x4*)(conv_b + ch), b1 = *(const f32x4*)(conv_b + ch + 4); s[0] = b0.x; s[1] = b0.y; s[2] = b0.z; s[3] = b0.w; s[4] = b1.x; s[5] = b1.y; s[6] = b1.z; s[7] = b1.w; }
#pragma unroll
                for (int j = 0; j < 4; ++j) { if (t - 3 + j >= 0) { const v4u v = *(const v4u*)(p - (size_t)(3 - j) * NIN);
                    const f32x4 w0 = *(const f32x4*)(conv_w + j * 1024 + ch), w1 = *(const f32x4*)(conv_w + j * 1024 + ch + 4);
                    s[0] += w0.x * blo(v.x); s[1] += w0.y * bhi(v.x); s[2] += w0.z * blo(v.y); s[3] += w0.w * bhi(v.y); s[4] += w1.x * blo(v.z); s[5] += w1.y * bhi(v.z); s[6] += w1.z * blo(v.w); s[7] += w1.w * bhi(v.w); } }
                v4u o; o.x = pk2(s[0], s[1]); o.y = pk2(s[2], s[3]); o.z = pk2(s[4], s[5]); o.w = pk2(s[6], s[7]);
                *(v4u*)(XC + (size_t)row * 1024 + ch) = o;
            }
        } }
        GSYNC();

        PH(3) { PHASE_IDS();
            const attn_body::AttnTensors AT{(const attn_body::bf16*)PROJ, (const attn_body::bf16*)(PROJ + 1024), (const attn_body::bf16*)(PROJ + 2048), (attn_body::bf16*)AO};
            attn_body::attn_phase<8>((char*)lds, AT, vcu, G);
            __syncthreads();
        }
        PH(9) { PHASE_IDS();
            pg8::Gemm gp{DP, PW, T, 256, 256, 1024, 256, 4, 512, 131072}; pg8::StaticOrder Sp; Sp.init(T, 256, G, bx, 4);
            pg8::EpiPool Ep{BR, GETP(7) + l * 1024, PROJ};
            pg8::gemm_phase<pg8::EpiPool, pg8::StaticOrder, true, true>(ldsl, gp, Sp, Ep);
        }
        PH(10) { PHASE_IDS();
            pg8::Gemm gl{XC, LW, T, 256, 128, 1024, 128, 8, 256, 65536}; pg8::StaticOrder Sl; Sl.init(T, 256, G, bx, 8);
            pg8::EpiLru El{XC, GETP(11) + l * 1024, GETP(13) + l * 1024, SPB, ABUF, UBUF};
            pg8::gemm_phase<pg8::EpiLru, pg8::StaticOrder, true, true>(ldsl, gl, Sl, El);
        }
        PH(11) { PHASE_IDS();
            for (int u = gw; u < 2048; u += NGW) memattn_unit(PROJ, MK, VT, BR, u >> 10, (u >> 8) & 3, u & 255, lane);
        }
        GSYNC();

        PH(4) { PHASE_IDS();
            float lam; const float* lam_vecs = GETP(4) + l * 256; const float* subln_g = GETP(5) + l * 128;
            { const float p1 = lam_vecs[lane] * lam_vecs[64 + lane], p2 = lam_vecs[128 + lane] * lam_vecs[192 + lane];
              lam = __expf(wave_sum(p1, lane)) - __expf(wave_sum(p2, lane)) + lambda_init; }
            const float osc = 1.0f - lambda_init;
            for (int m = gw; m < T; m += NGW) {
                const bf16* a0 = AO + (size_t)m * 2048 + lane * 16; const bf16* gp = PROJ + (size_t)m * NIN + 5632 + lane * 16;
                float d[16]; float ss = 0.f;
#pragma unroll
                for (int h2 = 0; h2 < 2; ++h2) { const v4u v0 = *(const v4u*)(a0 + h2 * 8), v1 = *(const v4u*)(a0 + 1024 + h2 * 8);
                    const float f0[8] = {blo(v0.x), bhi(v0.x), blo(v0.y), bhi(v0.y), blo(v0.z), bhi(v0.z), blo(v0.w), bhi(v0.w)};
                    const float f1[8] = {blo(v1.x), bhi(v1.x), blo(v1.y), bhi(v1.y), blo(v1.z), bhi(v1.z), blo(v1.w), bhi(v1.w)};
#pragma unroll
                    for (int j = 0; j < 8; ++j) { const float df = f0[j] - lam * f1[j]; d[h2 * 8 + j] = df; ss += df * df; } }
                ss += shx(ss, 1, lane); ss += shx(ss, 2, lane); ss += shx(ss, 4, lane);
                const float rstd = osc / sqrtf(ss * (1.0f / 128.0f) + EPS);
                const int c0 = (lane & 7) * 16;
#pragma unroll
                for (int h2 = 0; h2 < 2; ++h2) { const v4u gv = *(const v4u*)(gp + h2 * 8);
                    const float gf[8] = {blo(gv.x), bhi(gv.x), blo(gv.y), bhi(gv.y), blo(gv.z), bhi(gv.z), blo(gv.w), bhi(gv.w)};
                    const f32x4 s0 = *(const f32x4*)(subln_g + c0 + h2 * 8), s1 = *(const f32x4*)(subln_g + c0 + h2 * 8 + 4);
                    const float sg[8] = {s0.x, s0.y, s0.z, s0.w, s1.x, s1.y, s1.z, s1.w}; float y[8];
#pragma unroll
                    for (int j = 0; j < 8; ++j) y[j] = d[h2 * 8 + j] * rstd * sg[j] * gf[j];
                    v4u o; o.x = pk2(y[0], y[1]); o.y = pk2(y[2], y[3]); o.z = pk2(y[4], y[5]); o.w = pk2(y[6], y[7]);
                    *(v4u*)(BR + (size_t)m * BRW + lane * 16 + h2 * 8) = o; }
            }
            for (int u = gw; u < 2048; u += NGW) { const int sg = u >> 4, cgp = u & 15; const size_t base = (size_t)sg * 128 * 1024 + cgp * 64 + lane;
                float h = 0.f, P = 1.f;
#pragma unroll 8
                for (int t = 0; t < 128; ++t) { const float a = ABUF[base + (size_t)t * 1024], uu = UBUF[base + (size_t)t * 1024]; h = a * h + uu; P *= a; }
                AGGP[sg * 1024 + cgp * 64 + lane] = P; AGGH[sg * 1024 + cgp * 64 + lane] = h; }
        }
        GSYNC();

        PH(5) { PHASE_IDS(); for (int u = gw; u < 2048; u += NGW) { const int sg = u >> 4, cgp = u & 15, ch = cgp * 64 + lane; const size_t base = (size_t)sg * 128 * 1024 + ch;
            float h = 0.f;
            for (int s2 = sg & ~63; s2 < sg; ++s2) h = AGGP[s2 * 1024 + ch] * h + AGGH[s2 * 1024 + ch];
#pragma unroll 8
            for (int t = 0; t < 128; ++t) { const float a = ABUF[base + (size_t)t * 1024], uu = UBUF[base + (size_t)t * 1024]; h = a * h + uu;
                const size_t row = (size_t)sg * 128 + t; const float gt_ = pg8::bf2f(PROJ[row * NIN + 5632 + 2048 + ch]);
                BR[row * BRW + 2048 + ch] = (bf16)f2bf(h * gt_); }
        } }
        GSYNC();

        PH(6) { PHASE_IDS();
#pragma unroll 1
            for (int bi = 0; bi < 4; ++bi) {
                const int k0 = bi * 1024, kk = (bi == 3) ? 512 : 1024;
                pg8::Gemm g{BR + k0, WBR + k0, T, 2048, kk, BRW, BRW, 1, 0, 0}; pg8::StaticOrder S; S.init(T, 2048, G, bx);
                pg8::EpiBranch E{PROJ + 9216 + bi * 2048, NIN, M32, MB, 2048, (bi == 0) ? 0 : (bi == 3) ? 2 : 1};
                pg8::gemm_phase<pg8::EpiBranch, pg8::StaticOrder, true, true>(ldsl, g, S, E);
            }
        }
        GSYNC();

        PH(7) { PHASE_IDS();
            pg8::Gemm g{MB, WOUT, T, 2048, 2048, 2048, 2048, 1, 0, 0}; pg8::StaticOrder S; S.init(T, 2048, G, bx);
            pg8::EpiResF32 E{(l == 0) ? GETP(0) : X1, (l == 0) ? X1 : outp, 2048};
            pg8::gemm_phase<pg8::EpiResF32, pg8::StaticOrder, true, true>(ldsl, g, S, E);
        }
        GSYNC();
}
template <int PHM> __global__ void __launch_bounds__(NWAVES * 64, 2) mk_fwd(Args args, int l0, int l1) {
    extern __shared__ __attribute__((aligned(16))) unsigned char lds[];
    cg::grid_group grid = cg::this_grid();
    LAS unsigned char* ldsl = (LAS unsigned char*)lds;
    (void)args; (void)l1; (void)ldsl;
    if constexpr (((PHM) & ((PHM) - 1)) != 0) { layer_body<PHM>(lds, ldsl, grid, 0); layer_body<PHM>(lds, ldsl, grid, 1); }
    else if constexpr (PHM != 0x100) layer_body<PHM>(lds, ldsl, grid, l0);
    PH(8) { PHASE_IDS(); for (int m = gw; m < T; m += NGW) rms_row<true>(outp + (size_t)m * 2048, GETP(19), outp + (size_t)m * 2048, lane); }
}

extern "C" void kernel_launch(void* const* d_in, const int* in_sizes, int n_in, void* d_out, int out_size, void* d_ws, size_t ws_size, hipStream_t stream) {
    static int grid = 0;
    if (grid == 0) {
        if (n_in != 20 || out_size != T * DMODEL || ws_size < WS_END) { fprintf(stderr, "kernel_launch: unexpected shapes / workspace (n_in %d out %d ws %zu, need %zu)\n", n_in, out_size, ws_size, (size_t)WS_END); grid = -1; return; }
        int dev = 0, cus = 0, per_cu = 0;
        if (hipGetDevice(&dev) != hipSuccess || hipDeviceGetAttribute(&cus, hipDeviceAttributeMultiprocessorCount, dev) != hipSuccess) { grid = -1; return; }
#if !MK_MULTI
        if (hipFuncSetAttribute((const void*)mk_fwd<0xfff>, hipFuncAttributeMaxDynamicSharedMemorySize, LDS_BYTES) != hipSuccess) { grid = -1; return; }
        if (hipOccupancyMaxActiveBlocksPerMultiprocessor(&per_cu, (const void*)mk_fwd<0xfff>, NWAVES * 64, LDS_BYTES) != hipSuccess || per_cu < 1) { fprintf(stderr, "kernel_launch: occupancy query says %d\n", per_cu); }
#endif
        (void)per_cu;
        (void)hipGetLastError();
        grid = cus;
    }
    if (grid < 0) return;
    Args a{};
    for (int i = 0; i < 20; ++i) a.in[i] = (const float*)d_in[i];
    a.out = (float*)d_out; a.ws = (unsigned char*)d_ws;
#if MK_MULTI
#define LAUNCH1(MASK, L0, L1) do { static bool once_##MASK = false; if (!once_##MASK) { (void)hipFuncSetAttribute((const void*)mk_fwd<MASK>, hipFuncAttributeMaxDynamicSharedMemorySize, LDS_BYTES); once_##MASK = true; } \
        hipLaunchKernelGGL(mk_fwd<MASK>, dim3(grid), dim3(NWAVES * 64), LDS_BYTES, stream, a, (L0), (L1)); } while (0)
    for (int l = 0; l < 2; ++l) {
        LAUNCH1(0x001, l, l + 1); LAUNCH1(0x002, l, l + 1); LAUNCH1(0x004, l, l + 1); LAUNCH1(0x008, l, l + 1); LAUNCH1(0x200, l, l + 1); LAUNCH1(0x400, l, l + 1); LAUNCH1(0x800, l, l + 1);
        LAUNCH1(0x010, l, l + 1); LAUNCH1(0x020, l, l + 1); LAUNCH1(0x040, l, l + 1); LAUNCH1(0x080, l, l + 1);
    }
    LAUNCH1(0x100, 0, 0);
#else
    int l0 = 0, l1 = 2;
    void* kargs[] = {&a, &l0, &l1};
    hipError_t e = hipLaunchCooperativeKernel((const void*)mk_fwd<0xfff>, dim3(grid), dim3(NWAVES * 64), kargs, LDS_BYTES, stream);
    if (e != hipSuccess) fprintf(stderr, "kernel_launch: cooperative launch failed: %s (grid %d)\n", hipGetErrorString(e), grid);
#endif
}
```

```cpp
#include <hip/hip_runtime.h>
#include <hip/hip_cooperative_groups.h>
#include <cstdio>
#include <cstdint>
namespace pg8 {
#define PG8_LAS __attribute__((address_space(3)))
typedef unsigned short bf16_t;
typedef short bf16x8 __attribute__((ext_vector_type(8)));
typedef float f32x4 __attribute__((ext_vector_type(4)));
typedef unsigned u32x4 __attribute__((ext_vector_type(4)));
constexpr int BM = 256, BK = 64, HALF = 128, HTB = HALF * BK * 2  , STAGE_BYTES = 8 * HTB, NXCD = 8, WGM = 8;

__host__ __device__ __forceinline__ int lds_byte(int r, int c) { const int st = (r >> 4) * 2 + (c >> 5), rr = r & 15, cc = c & 31, ob = rr * 64 + cc * 2; return st * 1024 + (ob ^ (((ob >> 9) & 1) << 5)); }
__host__ __device__ __forceinline__ void stage_rc(int b, int& R, int& C) { const int st = b / 1024, sb = b % 1024, swz = sb ^ (((sb >> 9) & 1) << 5); R = (st >> 1) * 16 + swz / 64; C = (st & 1) * 32 + (swz % 64) / 2; }
__host__ __device__ __forceinline__ int perm32(int rho) { const int n = rho >> 4, i = rho & 15; return 8 * (i >> 2) + 4 * n + (i & 3); }

struct Unit { int pm, pn, pg; };
struct Gemm { const bf16_t* A; const bf16_t* Bt; int M, N, K, lda, ldb, ng; size_t gA, gB; };

struct StaticOrder {
    int nM, nN, nwg, G, c, per;
    __host__ __device__ void init(int M, int N, int G_, int c_, int ng = 1) { nM = M / BM; nN = N / BM; per = nM * nN; nwg = per * ng; G = G_; c = c_; }
    __host__ __device__ bool next(int i, Unit& u) const {
        const long L = (long)i * G + c; if (L >= nwg) return false;
        int wgid = (int)L; { const int q = nwg / NXCD, r = nwg % NXCD, xcd = wgid % NXCD, off = wgid / NXCD; wgid = (xcd < r ? xcd * (q + 1) : r * (q + 1) + (xcd - r) * q) + off; }
        u.pg = wgid / per; wgid -= u.pg * per;
        const int nig = WGM * nN, gid = wgid / nig, fm = gid * WGM, gsz = (nM - fm) < WGM ? (nM - fm) : WGM;
        u.pm = fm + ((wgid % nig) % gsz); u.pn = (wgid % nig) / gsz; return true;
    }
    __device__ __forceinline__ void a_ready(const Unit&) const {}
    __device__ __forceinline__ void done(const Unit&) const {}
};

__device__ __forceinline__ unsigned cvt_pk_bf16(float lo, float hi) { unsigned r; asm volatile("v_cvt_pk_bf16_f32 %0, %1, %2" : "=v"(r) : "v"(lo), "v"(hi)); return r; }
typedef float f32x2 __attribute__((ext_vector_type(2)));
__device__ __forceinline__ f32x2 gelu_pk(f32x2 v) {
    const f32x2 av = __builtin_elementwise_abs(v), d = av * 0.2316418882f + 1.0f;
    f32x2 t; t.x = __builtin_amdgcn_rcpf(d.x); t.y = __builtin_amdgcn_rcpf(d.y);
    f32x2 q = t * 0.5307027145f + (-0.7265760135f); q = q * t + 0.7107068705f; q = q * t + (-0.142248368f); q = q * t + 0.127414796f; q = q * t;
    const f32x2 s = (v * v) * (-0.72134752044f);
    f32x2 e; e.x = __builtin_amdgcn_exp2f(s.x); e.y = __builtin_amdgcn_exp2f(s.y);
    const f32x2 m = v * (q * e), r = v - m;
    f32x2 o; o.x = v.x < 0.f ? m.x : r.x; o.y = v.y < 0.f ? m.y : r.y; return o;
}

template <class Epi, class Sched, bool ALIGN_EPI = false, bool SP2 = false>
__device__ __forceinline__ void gemm_phase(PG8_LAS unsigned char* lds, const Gemm g, const Sched& S, const Epi& E, int tid) {
    asm volatile("" : "+v"(tid));
    const int wid = __builtin_amdgcn_readfirstlane(tid >> 6), lane = tid & 63, wr = wid >> 2, wc = wid & 3, fr = lane & 15, fq = lane >> 4;
    int K = g.K; asm volatile("" : "+s"(K)); const int nt = K / BK;
    unsigned voffA[2], voffB[2];
#pragma unroll
    for (int i = 0; i < 2; ++i) { int R, C; stage_rc(tid * 16 + i * 8192, R, C); const int Rb = Epi::PERM ? ((R & ~31) + perm32(R & 31)) : R;
        voffA[i] = (unsigned)(R * g.lda + C) * 2u; voffB[i] = (unsigned)(Rb * g.ldb + C) * 2u; }
    const size_t kstep = (size_t)(BK * 2);
    const size_t hstepA = (size_t)HALF * g.lda * 2, hstepB = (size_t)HALF * g.ldb * 2;
    const size_t tstepA = 2 * hstepA, tstepB = 2 * hstepB;
    const unsigned ldsw = (unsigned)wid * 1024u;
    const int aoff = lds_byte(wr * 64 + fr, fq * 8), boff = lds_byte(wc * 32 + fr, fq * 8);
#define PG8_SA(b, h) (((b) * 2 + (h)) * HTB)
#define PG8_SB(b, h) ((4 + (b) * 2 + (h)) * HTB)
#define PG8_STAGE(bufoff, gbase, voff) do { _Pragma("unroll") for (int _i = 0; _i < 2; ++_i) \
        __builtin_amdgcn_global_load_lds((const unsigned*)((const char*)(gbase) + (voff)[_i]), (PG8_LAS unsigned*)(lds + (bufoff) + ldsw + _i * 8192), 16, 0, 0); } while (0)
#define PG8_LDA(dst, b, h) do { _Pragma("unroll") for (int m = 0; m < 4; ++m) _Pragma("unroll") for (int k = 0; k < 2; ++k) dst[m][k] = *(const PG8_LAS bf16x8*)(lds + PG8_SA(b, h) + aoff + m * 2048 + k * 1024); } while (0)
#define PG8_LDB(dst, b, h) do { _Pragma("unroll") for (int n = 0; n < 2; ++n) _Pragma("unroll") for (int k = 0; k < 2; ++k) dst[n][k] = *(const PG8_LAS bf16x8*)(lds + PG8_SB(b, h) + boff + n * 2048 + k * 1024); } while (0)
#define PG8_MMA(ai, bj, At, Bt) do { __builtin_amdgcn_s_setprio(1); _Pragma("unroll") for (int m = 0; m < 4; ++m) _Pragma("unroll") for (int n = 0; n < 2; ++n) _Pragma("unroll") for (int k = 0; k < 2; ++k) \
        acc[ai][bj][m][n] = __builtin_amdgcn_mfma_f32_16x16x32_bf16(Bt[n][k], At[m][k], acc[ai][bj][m][n], 0, 0, 0); __builtin_amdgcn_s_setprio(0); } while (0)
#define PG8_WAIT_V(n) asm volatile("s_waitcnt vmcnt(" #n ")" ::: "memory")
#define PG8_WAIT_L(n) asm volatile("s_waitcnt lgkmcnt(" #n ")" ::: "memory")
#define PG8_BAR __builtin_amdgcn_s_barrier()
#define PG8_SCHED __builtin_amdgcn_sched_barrier(0)
    Unit cur, nxt; int ui = 0;
    if (!S.next(0, cur)) return;
    f32x4 acc[2][2][4][2];
#pragma unroll
    for (int a = 0; a < 2; ++a)
#pragma unroll
        for (int b = 0; b < 2; ++b)
#pragma unroll
            for (int m = 0; m < 4; ++m)
#pragma unroll
                for (int n = 0; n < 2; ++n) acc[a][b][m][n] = (f32x4){0.f, 0.f, 0.f, 0.f};
    bf16x8 At[4][2], B0[2][2], B1[2][2];
    const char* cA = (const char*)g.A + (size_t)cur.pg * g.gA + (size_t)cur.pm * tstepA; const char* cB = (const char*)g.Bt + (size_t)cur.pg * g.gB + (size_t)cur.pn * tstepB;
    S.a_ready(cur);
    if constexpr (SP2) {
        PG8_STAGE(PG8_SB(0, 0), cB, voffB); PG8_STAGE(PG8_SB(0, 1), cB + hstepB, voffB); PG8_STAGE(PG8_SA(0, 0), cA, voffA); PG8_STAGE(PG8_SA(0, 1), cA + hstepA, voffA);
        if (wr == 1) PG8_BAR;
        PG8_WAIT_V(2); PG8_BAR;
        PG8_STAGE(PG8_SB(1, 0), cB + kstep, voffB); PG8_STAGE(PG8_SA(1, 0), cA + kstep, voffA); PG8_STAGE(PG8_SB(1, 1), cB + hstepB + kstep, voffB);
        PG8_WAIT_V(6); PG8_BAR;
    } else {
        PG8_STAGE(PG8_SB(0, 0), cB, voffB); PG8_STAGE(PG8_SA(0, 0), cA, voffA); PG8_STAGE(PG8_SB(0, 1), cB + hstepB, voffB); PG8_STAGE(PG8_SA(0, 1), cA + hstepA, voffA);
        if (wr == 1) PG8_BAR;
        PG8_WAIT_V(4); PG8_BAR;
        PG8_STAGE(PG8_SB(1, 0), cB + kstep, voffB); PG8_STAGE(PG8_SA(1, 0), cA + kstep, voffA); PG8_STAGE(PG8_SB(1, 1), cB + hstepB + kstep, voffB);
        PG8_WAIT_V(6); PG8_BAR;
    }
    for (;;) {
        const bool has_next = S.next(ui + 1, nxt);
        const char* nA = has_next ? (const char*)g.A + (size_t)nxt.pg * g.gA + (size_t)nxt.pm * tstepA : cA; const char* nB = has_next ? (const char*)g.Bt + (size_t)nxt.pg * g.gB + (size_t)nxt.pn * tstepB : cB;
#pragma unroll 1
        for (int t = 0; t < nt; t += 2) {
            if constexpr (Epi::HOOK) { if (t != 0 && (t & 15) == 0) E.hook(acc, cur, t >> 4, wr, wc, fr, fq); }
            const bool last = (t == nt - 2);
            const char* a1 = cA + (size_t)(t + 1) * kstep;
            const char* a2 = last ? nA : cA + (size_t)(t + 2) * kstep; const char* b2 = last ? nB : cB + (size_t)(t + 2) * kstep;
            const char* a3 = a2 + kstep; const char* b3 = b2 + kstep;
            if (last && has_next) S.a_ready(nxt);
            if constexpr (SP2) {
            PG8_LDB(B0, 0, 0); PG8_LDB(B1, 0, 1); PG8_SCHED; PG8_LDA(At, 0, 0); PG8_STAGE(PG8_SA(1, 1), a1 + hstepA, voffA);
            PG8_WAIT_V(8); PG8_WAIT_L(0); PG8_BAR; PG8_MMA(0, 0, At, B0); PG8_MMA(0, 1, At, B1); PG8_BAR; PG8_SCHED;
            PG8_LDA(At, 0, 1); PG8_STAGE(PG8_SB(0, 0), b2, voffB); PG8_STAGE(PG8_SB(0, 1), b2 + hstepB, voffB); PG8_STAGE(PG8_SA(0, 0), a2, voffA);
            PG8_WAIT_V(8); PG8_WAIT_L(0); PG8_BAR; PG8_MMA(1, 0, At, B0); PG8_MMA(1, 1, At, B1); PG8_BAR; PG8_SCHED;
            PG8_LDB(B0, 1, 0); PG8_LDB(B1, 1, 1); PG8_SCHED; PG8_LDA(At, 1, 0); PG8_STAGE(PG8_SA(0, 1), a2 + hstepA, voffA);
            PG8_WAIT_V(8); PG8_WAIT_L(0); PG8_BAR; PG8_MMA(0, 0, At, B0); PG8_MMA(0, 1, At, B1); PG8_BAR; PG8_SCHED;
            PG8_LDA(At, 1, 1); PG8_STAGE(PG8_SB(1, 0), b3, voffB); PG8_STAGE(PG8_SB(1, 1), b3 + hstepB, voffB); PG8_STAGE(PG8_SA(1, 0), a3, voffA);
            PG8_WAIT_V(8); PG8_WAIT_L(0); PG8_BAR; PG8_MMA(1, 0, At, B0); PG8_MMA(1, 1, At, B1); PG8_BAR; PG8_SCHED;
            } else {
            PG8_LDB(B0, 0, 0); PG8_SCHED; PG8_LDA(At, 0, 0); PG8_STAGE(PG8_SA(1, 1), a1 + hstepA, voffA);
            PG8_WAIT_L(8); PG8_BAR; PG8_WAIT_L(0); PG8_MMA(0, 0, At, B0); PG8_BAR; PG8_SCHED;
            PG8_LDB(B1, 0, 1); PG8_STAGE(PG8_SB(0, 0), b2, voffB);
            PG8_BAR; PG8_WAIT_L(0); PG8_MMA(0, 1, At, B1); PG8_BAR;
            PG8_LDA(At, 0, 1); PG8_STAGE(PG8_SA(0, 0), a2, voffA);
            PG8_BAR; PG8_WAIT_L(0); PG8_MMA(1, 0, At, B0); PG8_BAR; PG8_SCHED;
            PG8_STAGE(PG8_SB(0, 1), b2 + hstepB, voffB);
            PG8_WAIT_V(6); PG8_BAR; PG8_MMA(1, 1, At, B1); PG8_BAR;
            PG8_LDB(B0, 1, 0); PG8_SCHED; PG8_LDA(At, 1, 0); PG8_STAGE(PG8_SA(0, 1), a2 + hstepA, voffA);
            PG8_WAIT_L(8); PG8_BAR; PG8_WAIT_L(0); PG8_MMA(0, 0, At, B0); PG8_BAR; PG8_SCHED;
            PG8_LDB(B1, 1, 1); PG8_STAGE(PG8_SB(1, 0), b3, voffB);
            PG8_BAR; PG8_WAIT_L(0); PG8_MMA(0, 1, At, B1); PG8_BAR;
            PG8_LDA(At, 1, 1); PG8_STAGE(PG8_SA(1, 0), a3, voffA);
            PG8_BAR; PG8_WAIT_L(0); PG8_MMA(1, 0, At, B0); PG8_BAR; PG8_SCHED;
            PG8_STAGE(PG8_SB(1, 1), b3 + hstepB, voffB);
            PG8_WAIT_V(6); PG8_BAR; PG8_MMA(1, 1, At, B1); PG8_BAR;
            }
        }
        if constexpr (ALIGN_EPI) { if (wr == 0) PG8_BAR; }
        if constexpr (!Epi::AFTER_DRAIN) { E(acc, cur, wr, wc, fr, fq); S.done(cur); }
        if (!has_next) break;
#pragma unroll
        for (int a = 0; a < 2; ++a)
#pragma unroll
            for (int b = 0; b < 2; ++b)
#pragma unroll
                for (int m = 0; m < 4; ++m)
#pragma unroll
                    for (int n = 0; n < 2; ++n) acc[a][b][m][n] = (f32x4){0.f, 0.f, 0.f, 0.f};
        cur = nxt; cA = nA; cB = nB; ++ui;
        if constexpr (ALIGN_EPI) { if (wr == 1) PG8_BAR; }
    }
    PG8_WAIT_V(0);
    if constexpr (!ALIGN_EPI) { if (wr == 0) PG8_BAR; }
    PG8_BAR;
    if constexpr (Epi::AFTER_DRAIN) { E.fused(acc, cur, wr, wc, fr, fq, lds, wid, lane); S.done(cur); }
#undef PG8_SA
#undef PG8_SB
#undef PG8_STAGE
#undef PG8_LDA
#undef PG8_LDB
#undef PG8_MMA
#undef PG8_WAIT_V
#undef PG8_WAIT_L
#undef PG8_BAR
#undef PG8_SCHED
}
}
namespace pg8 {
typedef unsigned u32x2 __attribute__((ext_vector_type(2)));
constexpr float QSCALE = 0.125f * 1.4426950408889634f;
__device__ __forceinline__ float sigm(float v) { return __builtin_amdgcn_rcpf(1.0f + __builtin_amdgcn_exp2f(-1.4426950408889634f * v)); }
__device__ __forceinline__ float bf2f(unsigned short b) { return __builtin_bit_cast(float, (unsigned)b << 16); }
__device__ __forceinline__ float bflo(unsigned w) { return __builtin_bit_cast(float, w << 16); }
__device__ __forceinline__ float bfhi(unsigned w) { return __builtin_bit_cast(float, w & 0xffff0000u); }

struct EpiBf16Act {
    static constexpr bool PERM = true, AFTER_DRAIN = false, HOOK = false;
    bf16_t* O; int ldc; int kind; bf16_t* QKVC;
    __device__ __forceinline__ void operator()(const f32x4 (&acc)[2][2][4][2], const Unit& u, int wr, int wc, int fr, int fq) const {
        int mode = 0; float sc = 1.f;
        if (kind == 1) { if (u.pn < 4) sc = QSCALE; else if (u.pn >= 36) mode = 2; else if (u.pn >= 22) mode = 1;   }
        const int row0 = u.pm * BM + wr * 64 + fr, col0 = u.pn * BM + wc * 32 + 8 * fq;
        const bool compact = (kind == 1) && (u.pn < 12);
        const int csec = u.pn >> 2, ccol = (u.pn & 3) * BM + wc * 32 + 8 * fq;
#pragma unroll
        for (int ai = 0; ai < 2; ++ai)
#pragma unroll
            for (int m = 0; m < 4; ++m) { const int rr = row0 + ai * HALF + m * 16; bf16_t* rowp = O + (size_t)rr * ldc + col0;
                if (compact) rowp = QKVC + (size_t)csec * (16384u * 1024u) + ((size_t)((rr >> 13) * 16 + (ccol >> 6)) * 8192 + (rr & 8191)) * 64 + (ccol & 63);
#pragma unroll
                for (int bj = 0; bj < 2; ++bj) { f32x4 v0 = acc[ai][bj][m][0] * sc, v1 = acc[ai][bj][m][1] * sc;
                    if (mode != 0) {
#pragma unroll
                        for (int j = 0; j < 4; ++j) { const float s0 = sigm(v0[j]), s1 = sigm(v1[j]); v0[j] = (mode == 1) ? v0[j] * s0 : s0; v1[j] = (mode == 1) ? v1[j] * s1 : s1; } }
                    u32x4 w; w.x = cvt_pk_bf16(v0[0], v0[1]); w.y = cvt_pk_bf16(v0[2], v0[3]); w.z = cvt_pk_bf16(v1[0], v1[1]); w.w = cvt_pk_bf16(v1[2], v1[3]);
                    *(u32x4*)(rowp + (compact ? bj * (2 * 8192 * 64) : bj * HALF)) = w; } }
    }
};
template <bool BB, bool OB> struct EpiRes {
    static constexpr bool PERM = false, AFTER_DRAIN = false, HOOK = false;
    const void* base; void* out; int ldc;
    __device__ __forceinline__ void operator()(const f32x4 (&acc)[2][2][4][2], const Unit& u, int wr, int wc, int fr, int fq) const {
        const int col0 = u.pn * BM + wc * 32 + 4 * fq;
#pragma unroll
        for (int ai = 0; ai < 2; ++ai) { f32x4 b[4][2][2];
#pragma unroll
            for (int m = 0; m < 4; ++m) { const size_t off = (size_t)(u.pm * BM + ai * HALF + wr * 64 + m * 16 + fr) * ldc + col0;
#pragma unroll
                for (int bj = 0; bj < 2; ++bj)
#pragma unroll
                    for (int n = 0; n < 2; ++n) { const size_t o2 = off + bj * HALF + n * 16;
                        if (BB) { const u32x2 w = *(const u32x2*)((const bf16_t*)base + o2); b[m][bj][n] = (f32x4){bflo(w.x), bfhi(w.x), bflo(w.y), bfhi(w.y)}; }
                        else b[m][bj][n] = *(const f32x4*)((const float*)base + o2); } }
#pragma unroll
            for (int m = 0; m < 4; ++m) { const size_t off = (size_t)(u.pm * BM + ai * HALF + wr * 64 + m * 16 + fr) * ldc + col0;
#pragma unroll
                for (int bj = 0; bj < 2; ++bj)
#pragma unroll
                    for (int n = 0; n < 2; ++n) { const size_t o2 = off + bj * HALF + n * 16; const f32x4 v = b[m][bj][n] + acc[ai][bj][m][n];
                        if (OB) { u32x2 w; w.x = cvt_pk_bf16(v[0], v[1]); w.y = cvt_pk_bf16(v[2], v[3]); *(u32x2*)((bf16_t*)out + o2) = w; }
                        else *(f32x4*)((float*)out + o2) = v; } }
            asm volatile("" ::: "memory"); }
    }
};
struct EpiBranchFused {
    static constexpr bool PERM = false, AFTER_DRAIN = false, HOOK = true;
    const bf16_t* gate; bf16_t* ob;
    __device__ __forceinline__ void hook(f32x4 (&acc)[2][2][4][2], const Unit& u, int j, int wr, int wc, int fr, int fq) const {
        const unsigned col0 = (unsigned)(u.pn * BM + wc * 32 + 4 * fq); const char* gb = (const char*)gate;
#pragma unroll
        for (int ai = 0; ai < 2; ++ai) { u32x2 go[4][2][2], gn[4][2][2];
#pragma unroll
            for (int m = 0; m < 4; ++m) { const unsigned row = (unsigned)(u.pm * BM + ai * HALF + wr * 64 + m * 16 + fr);
#pragma unroll
                for (int bj = 0; bj < 2; ++bj)
#pragma unroll
                    for (int n = 0; n < 2; ++n) { const unsigned off = (row * 17408u + (unsigned)(j - 1) * 2048u + col0 + bj * HALF + n * 16) * 2u;
                        go[m][bj][n] = *(const u32x2*)(gb + (size_t)off); gn[m][bj][n] = *(const u32x2*)(gb + (size_t)(off + 4096u)); } }
#pragma unroll
            for (int m = 0; m < 4; ++m)
#pragma unroll
                for (int bj = 0; bj < 2; ++bj)
#pragma unroll
                    for (int n = 0; n < 2; ++n) { const u32x2 o = go[m][bj][n], g = gn[m][bj][n]; f32x4 v = acc[ai][bj][m][n];
                        v[0] *= bflo(o.x) * __builtin_amdgcn_rcpf(fmaxf(bflo(g.x), 1e-30f)); v[1] *= bfhi(o.x) * __builtin_amdgcn_rcpf(fmaxf(bfhi(g.x), 1e-30f));
                        v[2] *= bflo(o.y) * __builtin_amdgcn_rcpf(fmaxf(bflo(g.y), 1e-30f)); v[3] *= bfhi(o.y) * __builtin_amdgcn_rcpf(fmaxf(bfhi(g.y), 1e-30f));
                        acc[ai][bj][m][n] = v; }
            asm volatile("" ::: "memory"); }
    }
    __device__ __forceinline__ void operator()(const f32x4 (&acc)[2][2][4][2], const Unit& u, int wr, int wc, int fr, int fq) const {
        const unsigned col0 = (unsigned)(u.pn * BM + wc * 32 + 4 * fq); const char* gb = (const char*)gate; char* obp = (char*)ob;
#pragma unroll
        for (int ai = 0; ai < 2; ++ai) { u32x2 gw[4][2][2];
#pragma unroll
            for (int m = 0; m < 4; ++m) { const unsigned row = (unsigned)(u.pm * BM + ai * HALF + wr * 64 + m * 16 + fr);
#pragma unroll
                for (int bj = 0; bj < 2; ++bj)
#pragma unroll
                    for (int n = 0; n < 2; ++n) gw[m][bj][n] = *(const u32x2*)(gb + (size_t)((row * 17408u + 3u * 2048u + col0 + bj * HALF + n * 16) * 2u)); }
#pragma unroll
            for (int m = 0; m < 4; ++m) { const unsigned row = (unsigned)(u.pm * BM + ai * HALF + wr * 64 + m * 16 + fr);
#pragma unroll
                for (int bj = 0; bj < 2; ++bj)
#pragma unroll
                    for (int n = 0; n < 2; ++n) { const unsigned c = col0 + bj * HALF + n * 16; const u32x2 g = gw[m][bj][n]; const f32x4 v = acc[ai][bj][m][n];
                        u32x2 w; w.x = cvt_pk_bf16(v[0] * bflo(g.x), v[1] * bfhi(g.x)); w.y = cvt_pk_bf16(v[2] * bflo(g.y), v[3] * bfhi(g.y));
                        *(u32x2*)(obp + (size_t)((row * 2048u + c) * 2u)) = w; } }
            asm volatile("" ::: "memory"); }
    }
};
struct EpiPool {
    static constexpr bool PERM = true, AFTER_DRAIN = false, HOOK = false;
    bf16_t* BR; const float* scale; const bf16_t* PROJ;
    __device__ __forceinline__ void operator()(const f32x4 (&acc)[2][2][4][2], const Unit& u, int wr, int wc, int fr, int fq) const {
        const unsigned row0 = (unsigned)(u.pm * BM + wr * 64 + fr), ch0 = (unsigned)(u.pg * 256 + wc * 32 + 8 * fq);
        const char* gb = (const char*)PROJ; char* ob = (char*)BR;
#pragma unroll
        for (int bj = 0; bj < 2; ++bj) { const unsigned ch = ch0 + bj * HALF; const f32x4 s0 = *(const f32x4*)(scale + ch), s1 = *(const f32x4*)(scale + ch + 4);
            u32x4 gwv[2][4];
#pragma unroll
            for (int ai = 0; ai < 2; ++ai)
#pragma unroll
                for (int m = 0; m < 4; ++m) { const unsigned row = row0 + ai * HALF + m * 16; gwv[ai][m] = *(const u32x4*)(gb + (size_t)(row * 34816u + (6656u + ch) * 2u)); }
#pragma unroll
            for (int ai = 0; ai < 2; ++ai)
#pragma unroll
                for (int m = 0; m < 4; ++m) { const unsigned row = row0 + ai * HALF + m * 16; const u32x4 gw = gwv[ai][m];
                    f32x4 v0 = acc[ai][bj][m][0] * s0, v1 = acc[ai][bj][m][1] * s1;
                    u32x4 w; w.x = cvt_pk_bf16(v0[0] * bflo(gw.x), v0[1] * bfhi(gw.x)); w.y = cvt_pk_bf16(v0[2] * bflo(gw.y), v0[3] * bfhi(gw.y));
                    w.z = cvt_pk_bf16(v1[0] * bflo(gw.z), v1[1] * bfhi(gw.z)); w.w = cvt_pk_bf16(v1[2] * bflo(gw.w), v1[3] * bfhi(gw.w));
                    *(u32x4*)(ob + (size_t)(row * 7168u + (1024u + ch) * 2u)) = w; }
            asm volatile("" ::: "memory"); }
    }
};
struct EpiLru {
    static constexpr bool PERM = false, AFTER_DRAIN = false, HOOK = false;
    const bf16_t* XC; const float *ba, *bx, *lam; bf16_t *LA, *UB;
    __device__ __forceinline__ void operator()(const f32x4 (&acc)[2][2][4][2], const Unit& u, int wr, int wc, int fr, int fq) const {
        const char* xb = (const char*)XC; char* ab = (char*)LA; char* ub = (char*)UB;
#pragma unroll
        for (int n = 0; n < 2; ++n) { const unsigned ch = (unsigned)(u.pg * 128 + wc * 32 + n * 16 + 4 * fq);
            const f32x4 bav = *(const f32x4*)(ba + ch), bxv = *(const f32x4*)(bx + ch), sp = *(const f32x4*)(lam + ch);
            u32x2 xwv[2][4];
#pragma unroll
            for (int ai = 0; ai < 2; ++ai)
#pragma unroll
                for (int m = 0; m < 4; ++m) { const unsigned row = (unsigned)(u.pm * BM + ai * HALF + wr * 64 + m * 16 + fr); xwv[ai][m] = *(const u32x2*)(xb + (size_t)((row * 1024u + ch) * 2u)); }
#pragma unroll
            for (int ai = 0; ai < 2; ++ai)
#pragma unroll
                for (int m = 0; m < 4; ++m) { const unsigned row = (unsigned)(u.pm * BM + ai * HALF + wr * 64 + m * 16 + fr); const unsigned off = (row * 1024u + ch) * 2u;
                    const u32x2 xw = xwv[ai][m]; const float xc[4] = {bflo(xw.x), bfhi(xw.x), bflo(xw.y), bfhi(xw.y)};
                    const f32x4 rp = acc[ai][0][m][n] + bav, ip = acc[ai][1][m][n] + bxv;
                    u32x2 lw; lw.x = cvt_pk_bf16(sp[0] * sigm(rp[0]), sp[1] * sigm(rp[1])); lw.y = cvt_pk_bf16(sp[2] * sigm(rp[2]), sp[3] * sigm(rp[3]));
                    const float la[4] = {bflo(lw.x), bfhi(lw.x), bflo(lw.y), bfhi(lw.y)}; float uv[4];
#pragma unroll
                    for (int j = 0; j < 4; ++j) { const float ig = sigm(ip[j]); const float a = __builtin_amdgcn_exp2f(la[j]);
                        float mult = __builtin_sqrtf((1.0f - a) * (1.0f + a)); if ((row & 8191u) == 0u) mult = 1.0f;
                        uv[j] = mult * ig * xc[j]; }
                    u32x2 uw; uw.x = cvt_pk_bf16(uv[0], uv[1]); uw.y = cvt_pk_bf16(uv[2], uv[3]);
                    *(u32x2*)(ab + (size_t)off) = lw; *(u32x2*)(ub + (size_t)off) = uw; }
            asm volatile("" ::: "memory"); }
    }
};
}
#include <hip/hip_bf16.h>
#include <cmath>
namespace attn_body {
using bf16=__hip_bfloat16;
using bf16x8=__attribute__((ext_vector_type(8)))short;
using s16x4=__attribute__((ext_vector_type(4)))short;
using f32x16=__attribute__((ext_vector_type(16)))float;
using u32x4=__attribute__((ext_vector_type(4)))unsigned;
constexpr int BATCH=2,NHEAD=16,SEQ=8192,D=64,DM=NHEAD*D,QP=64,OP=2048;
constexpr int NW=8,QBLK=32,QB=QBLK*NW,KVBLK=64,NQB=SEQ/QB;
constexpr int ATTN_PITCH=DM, ATTN_UNIT_ROWS=QB;
__device__ __forceinline__ int crow(int r,int hi){return (r&3)+8*(r>>2)+4*hi;}
#define SBAR() __builtin_amdgcn_sched_barrier(0)
__device__ __forceinline__ void cmask(f32x16&p0,f32x16&p1,int jb,int qrel,int hi){
  const float NEG=-INFINITY; int dlt=qrel-64*jb-4*hi; asm volatile("":"+v"(dlt));
  #pragma unroll
  for(int r=0;r<16;++r){const int cr=(r&3)+8*(r>>2); if(cr>dlt)p0[r]=NEG; if(cr+32>dlt)p1[r]=NEG;}
}

constexpr int NSLOT=3, SLOTB=8192;
constexpr int LDS_K=0, LDS_V=NSLOT*SLOTB, LDS_WS=LDS_V+NSLOT*2*SLOTB, LDS_OST=LDS_WS+NW*64*4, LDS_BYTES=LDS_OST+NW*4096;
constexpr float C2=0.125f*1.4426950408889634f;
__device__ __forceinline__ void glds16(const void*gsrc,unsigned lds_dst){unsigned keep;
  asm volatile("s_mov_b32 %0, m0\n\ts_mov_b32 m0, %2\n\ts_nop 0\n\tglobal_load_lds_dwordx4 %1, off\n\ts_mov_b32 m0, %0":"=&s"(keep):"v"(gsrc),"s"(lds_dst):"memory");}
__device__ __forceinline__ float max3f(float a,float b,float c){float r;asm("v_max3_f32 %0, %1, %2, %3":"=v"(r):"v"(a),"v"(b),"v"(c));return r;}
__device__ __forceinline__ float max2f(float a,float b){float r;asm("v_max_f32_e32 %0, %1, %2":"=v"(r):"v"(a),"v"(b));return r;}
__device__ __forceinline__ float fadd_s(float a,float b){float r;asm("v_add_f32_e32 %0, %1, %2":"=v"(r):"v"(a),"v"(b));return r;}
__device__ __forceinline__ float fsub_s(float a,float b){float r;asm("v_sub_f32_e32 %0, %1, %2":"=v"(r):"v"(a),"v"(b));return r;}
typedef float f32x2_t __attribute__((ext_vector_type(2))); typedef __bf16 bf16x2_t __attribute__((ext_vector_type(2)));
__device__ __forceinline__ unsigned cvtpk_s(float lo,float hi){f32x2_t v={lo,hi};bf16x2_t b=__builtin_convertvector(v,bf16x2_t);return __builtin_bit_cast(unsigned,b);}
__device__ __forceinline__ void glds16s(const void*sbase,unsigned voff,unsigned lds_dst){unsigned keep;
  asm volatile("s_mov_b32 %0, m0\n\ts_mov_b32 m0, %3\n\ts_nop 0\n\tglobal_load_lds_dwordx4 %1, %2\n\ts_mov_b32 m0, %0":"=&s"(keep):"v"(voff),"s"(sbase),"s"(lds_dst):"memory");}
#define WAIT_BAR(N) asm volatile("s_waitcnt vmcnt(" #N ") lgkmcnt(0)\n\ts_barrier":::"memory")

__device__ __forceinline__ void qkt(f32x16&p0,f32x16&p1,const char*Kslot,const bf16x8*qr,const f32x16&negm,int r32,int hi){
  const char*kb=Kslot+hi*1024+r32*16;
  #pragma unroll
  for(int d0=0;d0<4;++d0){
    const bf16x8 b0=*reinterpret_cast<const bf16x8*>(kb+d0*2048);
    const bf16x8 b1=*reinterpret_cast<const bf16x8*>(kb+d0*2048+512);
    if(d0==0){p0=__builtin_amdgcn_mfma_f32_32x32x16_bf16(b0,qr[0],negm,0,0,0);p1=__builtin_amdgcn_mfma_f32_32x32x16_bf16(b1,qr[0],negm,0,0,0);}
    else{p0=__builtin_amdgcn_mfma_f32_32x32x16_bf16(b0,qr[d0],p0,0,0,0);p1=__builtin_amdgcn_mfma_f32_32x32x16_bf16(b1,qr[d0],p1,0,0,0);}}
}
typedef __attribute__((address_space(3))) const char* lds_cptr;
typedef short v4i16_t __attribute__((ext_vector_type(4)));
__device__ __forceinline__ void kload8(bf16x8*kf,lds_cptr kp){
  kf[0]=*(const __attribute__((address_space(3))) bf16x8*)(kp);      kf[1]=*(const __attribute__((address_space(3))) bf16x8*)(kp+512);
  kf[2]=*(const __attribute__((address_space(3))) bf16x8*)(kp+2048); kf[3]=*(const __attribute__((address_space(3))) bf16x8*)(kp+2560);
  kf[4]=*(const __attribute__((address_space(3))) bf16x8*)(kp+4096); kf[5]=*(const __attribute__((address_space(3))) bf16x8*)(kp+4608);
  kf[6]=*(const __attribute__((address_space(3))) bf16x8*)(kp+6144); kf[7]=*(const __attribute__((address_space(3))) bf16x8*)(kp+6656);
}
__device__ __forceinline__ void kload2(bf16x8*kf,lds_cptr kp,int j){ kf[2*j]=*(const __attribute__((address_space(3))) bf16x8*)(kp+j*2048); kf[2*j+1]=*(const __attribute__((address_space(3))) bf16x8*)(kp+j*2048+512); }
__device__ __forceinline__ s16x4 vtr(lds_cptr p){ return __builtin_bit_cast(s16x4,__builtin_amdgcn_ds_read_tr16_b64_v4i16((__attribute__((address_space(3))) v4i16_t*)p)); }
__device__ __forceinline__ float rowmax(const f32x16&p0,const f32x16&p1){
  float a=max3f(p0[0],p0[1],p1[0]),b=max3f(p0[2],p0[3],p1[1]);a=max3f(a,p1[2],p1[3]);
  #pragma unroll
  for(int r=4;r<16;r+=4){a=max3f(a,p0[r],p0[r+1]);b=max3f(b,p0[r+2],p0[r+3]);a=max3f(a,p1[r],p1[r+1]);b=max3f(b,p1[r+2],p1[r+3]);}
  const float m=max2f(a,b);
  auto rr=__builtin_amdgcn_permlane32_swap(__float_as_uint(m),__float_as_uint(m),false,false);
  return max2f(__uint_as_float(rr[0]),__uint_as_float(rr[1]));
}
__device__ __forceinline__ void pv(f32x16*o,int vb,bf16x8 pa0,bf16x8 pa1,bf16x8 pa2,bf16x8 pa3){
  #pragma unroll
  for(int d0=0;d0<2;++d0){s16x4 lo[4],hi[4];
    #pragma unroll
    for(int ks=0;ks<4;++ks){
      asm volatile("ds_read_b64_tr_b16 %0,%1 offset:%c2":"=&v"(lo[ks]):"v"(vb),"i"(d0*4096+ks*1024):"memory");
      asm volatile("ds_read_b64_tr_b16 %0,%1 offset:%c2":"=&v"(hi[ks]):"v"(vb),"i"(d0*4096+ks*1024+512):"memory");}
    asm volatile("s_waitcnt lgkmcnt(0)":::"memory");SBAR();
    #define PK(k) (bf16x8){lo[k][0],lo[k][1],lo[k][2],lo[k][3],hi[k][0],hi[k][1],hi[k][2],hi[k][3]}
    o[d0]=__builtin_amdgcn_mfma_f32_32x32x16_bf16(pa0,PK(0),o[d0],0,0,0);
    o[d0]=__builtin_amdgcn_mfma_f32_32x32x16_bf16(pa1,PK(1),o[d0],0,0,0);
    o[d0]=__builtin_amdgcn_mfma_f32_32x32x16_bf16(pa2,PK(2),o[d0],0,0,0);
    o[d0]=__builtin_amdgcn_mfma_f32_32x32x16_bf16(pa3,PK(3),o[d0],0,0,0);
    #undef PK
  }
}

#ifndef ATTN_STORE16
#define ATTN_STORE16(p,v) (*(u32x4*)(p)=(v))
#endif
template<int THRL> __device__ __forceinline__ void attn_unit(int b,int h,int vcol,int ocol,int qb,const bf16*Q,const bf16*__restrict__ K,const bf16*__restrict__ V,bf16*O,char*shm,const int tid){
  const int lane=tid&63,r32=lane&31,hi=lane>>5; const int wid=__builtin_amdgcn_readfirstlane(tid>>6);
  const long rowbase=(long)b*SEQ; const int q0=qb*QB;
  const bf16*Qw=Q+((long)(b*NHEAD+h)*SEQ+q0+wid*QBLK)*QP;
  const bf16*Kh=K+(long)(b*NHEAD+h)*SEQ*QP,*Vh=V+(long)(b*NHEAD+vcol)*SEQ*QP;
  const unsigned lds0=(unsigned)(uintptr_t)shm;
  float*wsf=(float*)(shm+LDS_WS)+wid*64;
  const unsigned koff=(unsigned)(lane*QP+wid*8)*2u;
  const unsigned voff=(unsigned)((16*(wid&3)+(lane>>2))*QP+(wid>>2)*32+(lane&3)*8)*2u;
  const unsigned kdst=lds0+LDS_K+wid*1024, vdst=lds0+LDS_V+wid*1024;
  #define DMA_K(t,slot) glds16s(Kh+(long)(t)*KVBLK*QP,koff,(unsigned)__builtin_amdgcn_readfirstlane(kdst+(slot)))
  #define DMA_V(t,slot) do{ glds16s(Vh+(long)(t)*KVBLK*QP,voff,(unsigned)__builtin_amdgcn_readfirstlane(vdst+2*(slot))); glds16s(Vh+(long)SEQ*QP+(long)(t)*KVBLK*QP,voff,(unsigned)__builtin_amdgcn_readfirstlane(vdst+2*(slot)+SLOTB)); }while(0)
  const char*Kbase=shm+LDS_K; bf16x8 kf[8];
  const lds_cptr shm3=(lds_cptr)shm; const lds_cptr kp0=shm3+LDS_K+hi*1024+r32*16; const lds_cptr vp0=shm3+LDS_V+((lane>>4)&1)*32+(lane&3)*8+(4*hi+((lane&15)>>2))*64;
  const int NT=(q0+QB)/KVBLK;
  DMA_K(0,0);DMA_V(0,0);DMA_K(1,SLOTB);
  bf16x8 qr[4];
  #pragma unroll
  for(int d0=0;d0<4;++d0)qr[d0]=*reinterpret_cast<const bf16x8*>(&Qw[(long)r32*QP+d0*16+hi*8]);
  float mhat=0.f,l_reg=0.f;f32x16 o[4];o[0]=f32x16{};o[1]=f32x16{};o[2]=f32x16{};o[3]=f32x16{};f32x16 negm=f32x16{};asm volatile("":"+v"(negm));
  const int qrel=wid*QBLK+r32;
  #define CMASK(P0,P1,t) do{int jb_=(t)-(NT-4); if(jb_>=0)cmask(P0,P1,jb_,qrel,hi);}while(0)
  bool resc=false;
  #define START(P0,P1) do{ const float rm=rowmax(P0,P1); resc=false; \
    { const float dl=rm; mhat=fadd_s(mhat,dl); \
      _Pragma("unroll") for(int r=0;r<16;++r){P0[r]=fsub_s(P0[r],dl);P1[r]=fsub_s(P1[r],dl);} \
      _Pragma("unroll") for(int r=0;r<16;++r)negm[r]=-mhat; asm volatile("":"+v"(negm)); } \
    _Pragma("unroll") for(int r=0;r<16;++r)P0[r]=__builtin_amdgcn_exp2f(P0[r]); }while(0)
  #define RESC() do{ if(resc){ asm volatile("s_waitcnt lgkmcnt(0)":::"memory"); \
      _Pragma("unroll") for(int d_=0;d_<4;++d_) _Pragma("unroll") for(int r=0;r<16;++r)o[d_][r]*=wsf[crow(r,hi)]; } }while(0)
  f32x16 pA0,pA1,pB0,pB1;
  int sl_prev=0,sl_cur=0,sl_next=SLOTB;
  #define ROT() do{sl_prev=sl_cur;sl_cur=sl_next;sl_next=(sl_next==(NSLOT-1)*SLOTB)?0:sl_next+SLOTB;}while(0)
  DMA_K(2,2*SLOTB);
  WAIT_BAR(3);
  qkt(pA0,pA1,Kbase,qr,negm,r32,hi);asm volatile("s_nop 15\n\ts_nop 7":"+v"(pA0),"+v"(pA1));CMASK(pA0,pA1,0);
  START(pA0,pA1);
  _Pragma("unroll") for(int r=0;r<16;++r)pA1[r]=__builtin_amdgcn_exp2f(pA1[r]);
  WAIT_BAR(0);
  DMA_K(3,0);DMA_V(1,SLOTB);
  ROT();
  kload8(kf,kp0+sl_cur);
  WAIT_BAR(3);
  s16x4 vlo[4],vhi[4]; u32x4 pw0,pw1,pw2,pw3;
  #define PKW(P,B) cvtpk_s(P[B],P[B+1])
  #define PAF(k) __builtin_bit_cast(bf16x8,pw##k)
  #define VFS(i) (bf16x8){vlo[i][0],vlo[i][1],vlo[i][2],vlo[i][3],vhi[i][0],vhi[i][1],vhi[i][2],vhi[i][3]}
  #define PIN(x) asm volatile("":"+v"(x))
  #define MX3(a,b,c) __builtin_fmaxf(__builtin_fmaxf((a),(b)),(c))
  #define GAPA(MF,A0,A1,A2,A3,W0,W1,PW) do{ MF; sacc+=A0; sacc+=A1; sacc+=A2; sacc+=A3; PIN(sacc); W0; W1; PIN(PW); SBAR(); }while(0)
  #define EX(v) __builtin_amdgcn_exp2f(v)
  #define GAPB(MF,X,B) do{ MF; X[B]=EX(X[B]); X[B+1]=EX(X[B+1]); X[B+2]=EX(X[B+2]); X[B+3]=EX(X[B+3]); PIN(X); SBAR(); }while(0)
  #define GAPB2(MF,X,B) do{ MF; X[B]=EX(X[B]); X[B+1]=EX(X[B+1]); PIN(X); SBAR(); }while(0)
  #define VRDX(s,h,i) do{ vlo[s]=vtr(vp_+((h)*SLOTB+((i)>>2)*4096+((i)&3)*1024)); vhi[s]=vtr(vp_+((h)*SLOTB+((i)>>2)*4096+((i)&3)*1024+512)); SBAR(); }while(0)
  #define VRD(i) do{ vlo[i]=vtr(vp_+(((i)>>2)*4096+((i)&3)*1024)); vhi[i]=vtr(vp_+(((i)>>2)*4096+((i)&3)*1024+512)); }while(0)
  #define KRD(G,j) do{ if(G){ kload2(kf,kp0+sl_next,j); SBAR(); } }while(0)
  #define STEP(C0,C1,P0,P1,t,GK,GV,GL) do{ SBAR(); \
    const lds_cptr vp_=vp0+2*sl_prev; \
    SBAR(); float sacc=(P0[0]+P0[1]); \
    GAPA(C0=__builtin_amdgcn_mfma_f32_32x32x16_bf16(kf[0],qr[0],negm,0,0,0), P0[2],P0[3],P0[4],P0[5],     pw0[0]=PKW(P0,0), pw0[1]=PKW(P0,2), pw0); \
    GAPA(C1=__builtin_amdgcn_mfma_f32_32x32x16_bf16(kf[1],qr[0],negm,0,0,0), P0[6],P0[7],P0[8],P0[9],     pw0[2]=PKW(P0,4), pw0[3]=PKW(P0,6), pw0); \
    GAPA(C0=__builtin_amdgcn_mfma_f32_32x32x16_bf16(kf[2],qr[1],C0,0,0,0),   P0[10],P0[11],P0[12],P0[13], pw1[0]=PKW(P0,8), pw1[1]=PKW(P0,10), pw1); \
    GAPA(C1=__builtin_amdgcn_mfma_f32_32x32x16_bf16(kf[3],qr[1],C1,0,0,0),   P0[14],P0[15],P1[0],P1[1],   pw1[2]=PKW(P0,12),pw1[3]=PKW(P0,14), pw1); \
    VRDX(0,0,0); GAPA(C0=__builtin_amdgcn_mfma_f32_32x32x16_bf16(kf[4],qr[2],C0,0,0,0),   P1[2],P1[3],P1[4],P1[5],     pw2[0]=PKW(P1,0), pw2[1]=PKW(P1,2), pw2); \
    VRDX(1,0,4); GAPA(C1=__builtin_amdgcn_mfma_f32_32x32x16_bf16(kf[5],qr[2],C1,0,0,0),   P1[6],P1[7],P1[8],P1[9],     pw2[2]=PKW(P1,4), pw2[3]=PKW(P1,6), pw2); \
    VRDX(2,0,1); GAPA(C0=__builtin_amdgcn_mfma_f32_32x32x16_bf16(kf[6],qr[3],C0,0,0,0),   P1[10],P1[11],P1[12],P1[13], pw3[0]=PKW(P1,8), pw3[1]=PKW(P1,10), pw3); \
    VRDX(3,0,5); GAPA(C1=__builtin_amdgcn_mfma_f32_32x32x16_bf16(kf[7],qr[3],C1,0,0,0),   P1[14],P1[15],0.f,0.f,       pw3[2]=PKW(P1,12),pw3[3]=PKW(P1,14), pw3); \
    l_reg+=sacc; \
    if(GK){DMA_K((t)+3,sl_cur);} if(GV){DMA_V((t)+1,sl_next);} \
    CMASK(C0,C1,t); \
    { float a=MX3(C0[0],C0[1],C1[0]),b=MX3(C0[2],C0[3],C1[1]); a=MX3(a,C1[2],C1[3]); \
      _Pragma("unroll") for(int r=4;r<16;r+=4){a=MX3(a,C0[r],C0[r+1]);b=MX3(b,C0[r+2],C0[r+3]);a=MX3(a,C1[r],C1[r+1]);b=MX3(b,C1[r+2],C1[r+3]);} \
      float rm=__builtin_fmaxf(a,b); { auto rr=__builtin_amdgcn_permlane32_swap(__float_as_uint(rm),__float_as_uint(rm),false,false); rm=__builtin_fmaxf(__uint_as_float(rr[0]),__uint_as_float(rr[1])); } \
      resc=false; \
      if(__builtin_expect(__any(rm>(float)THRL),0)){ const float dl=__builtin_fmaxf(rm,0.f); mhat+=dl; \
        _Pragma("unroll") for(int r=0;r<16;++r){C0[r]-=dl;C1[r]-=dl;} \
        _Pragma("unroll") for(int r=0;r<16;++r)negm[r]=-mhat; asm volatile("":"+v"(negm)); \
        const float f=__builtin_amdgcn_exp2f(-dl); l_reg*=f; if(hi==0)wsf[r32]=f; resc=true; } } \
    SBAR(); \
    GAPB2(o[0]=__builtin_amdgcn_mfma_f32_32x32x16_bf16(PAF(0),VFS(0),o[0],0,0,0), C0,0); VRDX(0,0,2); \
    GAPB2(o[1]=__builtin_amdgcn_mfma_f32_32x32x16_bf16(PAF(0),VFS(1),o[1],0,0,0), C0,2); VRDX(1,0,6); \
    KRD(GL,0); GAPB2(o[0]=__builtin_amdgcn_mfma_f32_32x32x16_bf16(PAF(1),VFS(2),o[0],0,0,0), C0,4); VRDX(2,0,3); \
    KRD(GL,1); GAPB2(o[1]=__builtin_amdgcn_mfma_f32_32x32x16_bf16(PAF(1),VFS(3),o[1],0,0,0), C0,6); VRDX(3,0,7); \
    KRD(GL,2); GAPB2(o[0]=__builtin_amdgcn_mfma_f32_32x32x16_bf16(PAF(2),VFS(0),o[0],0,0,0), C0,8); VRDX(0,1,0); \
    KRD(GL,3); GAPB2(o[1]=__builtin_amdgcn_mfma_f32_32x32x16_bf16(PAF(2),VFS(1),o[1],0,0,0), C0,10); VRDX(1,1,4); \
    GAPB2(o[0]=__builtin_amdgcn_mfma_f32_32x32x16_bf16(PAF(3),VFS(2),o[0],0,0,0), C0,12); VRDX(2,1,1); \
    GAPB2(o[1]=__builtin_amdgcn_mfma_f32_32x32x16_bf16(PAF(3),VFS(3),o[1],0,0,0), C0,14); VRDX(3,1,5); \
    GAPB2(o[2]=__builtin_amdgcn_mfma_f32_32x32x16_bf16(PAF(0),VFS(0),o[2],0,0,0), C1,0); VRDX(0,1,2); \
    GAPB2(o[3]=__builtin_amdgcn_mfma_f32_32x32x16_bf16(PAF(0),VFS(1),o[3],0,0,0), C1,2); VRDX(1,1,6); \
    GAPB2(o[2]=__builtin_amdgcn_mfma_f32_32x32x16_bf16(PAF(1),VFS(2),o[2],0,0,0), C1,4); VRDX(2,1,3); \
    GAPB2(o[3]=__builtin_amdgcn_mfma_f32_32x32x16_bf16(PAF(1),VFS(3),o[3],0,0,0), C1,6); VRDX(3,1,7); \
    GAPB2(o[2]=__builtin_amdgcn_mfma_f32_32x32x16_bf16(PAF(2),VFS(0),o[2],0,0,0), C1,8); \
    GAPB2(o[3]=__builtin_amdgcn_mfma_f32_32x32x16_bf16(PAF(2),VFS(1),o[3],0,0,0), C1,10); \
    GAPB2(o[2]=__builtin_amdgcn_mfma_f32_32x32x16_bf16(PAF(3),VFS(2),o[2],0,0,0), C1,12); \
    GAPB2(o[3]=__builtin_amdgcn_mfma_f32_32x32x16_bf16(PAF(3),VFS(3),o[3],0,0,0), C1,14); \
    }while(0)
  int t=1;
  #undef CMASK
  #define CMASK(P0,P1,t) do{}while(0)
  for(;t+5<NT;t+=2){
    STEP(pB0,pB1,pA0,pA1,t,true,true,true);     WAIT_BAR(3); RESC(); ROT();
    STEP(pA0,pA1,pB0,pB1,t+1,true,true,true);   WAIT_BAR(3); RESC(); ROT();
  }
  #undef CMASK
  #define CMASK(P0,P1,t) do{int jb_=(t)-(NT-4); if(jb_>=0)cmask(P0,P1,jb_,qrel,hi);}while(0)
  #define ENDW(tt) do{ if((tt)+3<NT){WAIT_BAR(3);} else if((tt)+2<NT){WAIT_BAR(2);} else {WAIT_BAR(0);} }while(0)
  for(;t+1<NT;t+=2){
    STEP(pB0,pB1,pA0,pA1,t,(t+3<NT),(t+1<NT),(t+1<NT));       ENDW(t);   RESC(); ROT();
    STEP(pA0,pA1,pB0,pB1,t+1,(t+4<NT),(t+2<NT),(t+2<NT));     ENDW(t+1); RESC(); ROT();
  }
  STEP(pB0,pB1,pA0,pA1,NT-1,false,false,false); RESC();
  { float sacc=pB0[0]+pB0[1]; _Pragma("unroll") for(int r=2;r<16;++r)sacc+=pB0[r]; _Pragma("unroll") for(int r=0;r<16;++r)sacc+=pB1[r]; l_reg+=sacc;
    pw0=(u32x4){PKW(pB0,0),PKW(pB0,2),PKW(pB0,4),PKW(pB0,6)};pw1=(u32x4){PKW(pB0,8),PKW(pB0,10),PKW(pB0,12),PKW(pB0,14)};pw2=(u32x4){PKW(pB1,0),PKW(pB1,2),PKW(pB1,4),PKW(pB1,6)};pw3=(u32x4){PKW(pB1,8),PKW(pB1,10),PKW(pB1,12),PKW(pB1,14)};
    SBAR(); { const int vb0=(int)(unsigned)(uintptr_t)vp0; pv(o,vb0+2*sl_cur,PAF(0),PAF(1),PAF(2),PAF(3)); pv(o+2,vb0+2*sl_cur+SLOTB,PAF(0),PAF(1),PAF(2),PAF(3)); } }
  #undef PKW
  #undef PAF
  #undef VFS
  #undef PIN
  #undef MX3
  #undef GAPA
  #undef GAPB
  #undef GAPB2
  #undef VRDX
  #undef EX
  #undef VRD
  #undef KRD
  #undef STEP
  #undef ENDW
  int lane_e=lane; asm volatile("":"+v"(lane_e)); const int r32e=lane_e&31,hie=lane_e>>5;
  {auto rr=__builtin_amdgcn_permlane32_swap(__float_as_uint(l_reg),__float_as_uint(l_reg),false,false);l_reg=__uint_as_float(rr[0])+__uint_as_float(rr[1]);}
  if(hie==0)wsf[32+r32e]=l_reg;asm volatile("s_waitcnt lgkmcnt(0)":::"memory");
  float rli[16];
  #pragma unroll
  for(int r=0;r<16;++r)rli[r]=__builtin_amdgcn_rcpf(wsf[32+crow(r,hie)]);
  bf16*Ow=O+(rowbase+q0+wid*QBLK)*OP+ocol;
  { bf16*stg=(bf16*)(shm+LDS_OST)+wid*2048;
    #pragma unroll
    for(int hh=0;hh<2;++hh){
      #pragma unroll
      for(int r=0;r<16;++r){const int orow=crow(r,hie);
        #pragma unroll
        for(int d0=0;d0<2;++d0)stg[orow*64+d0*32+r32e]=__float2bfloat16(o[2*hh+d0][r]*rli[r]);}
      asm volatile("s_waitcnt lgkmcnt(0)":::"memory");
      #pragma unroll
      for(int i=0;i<4;++i){const int row=i*8+(lane_e>>3),ch=lane_e&7; const u32x4 v=*(const u32x4*)(stg+row*64+ch*8); ATTN_STORE16(Ow+(long)row*OP+hh*64+ch*8,v);}
      asm volatile("s_waitcnt lgkmcnt(0)":::"memory"); } }
  asm volatile("s_waitcnt lgkmcnt(0)\n\ts_barrier":::"memory");
  #undef DMA_K
  #undef DMA_V
  #undef CMASK
  #undef START
  #undef RESC
  #undef ROT
}
constexpr int ATTN_LDS_BYTES=LDS_BYTES;
struct AttnTensors { const bf16* Q; const bf16* K; const bf16* V; bf16* O; };
template<int THRL=8> __device__ __forceinline__ void attn_phase(char*lds,const AttnTensors&T,int vcu,int G,int tid){
  asm volatile("":"+v"(tid));
  const bool bal=(G==256); const int s=vcu&7;
  for(int i=0;;++i){ int bh,qb;
    if(bal){ if(i>=4)break; bh=vcu>>3; qb=(i==0)?s:(i==1)?15-s:(i==2)?16+s:31-s; }
    else{ const int u=vcu+i*G; if(u>=1024)break; qb=31-(u&31); bh=u>>5; }
    const int b=bh>>4,hc=bh&15,hd=hc>>1,c=hc&1;
    attn_unit<THRL>(b,hc,hd*2,c*1024+hd*128,qb,T.Q,T.K,T.V,T.O,lds,tid); }
}
#undef SBAR
#undef WAIT_BAR
}
namespace cg = cooperative_groups;
constexpr int NWAVES = 8;
constexpr int BATCH = 2, SEQ = 8192, DMODEL = 2048, T = BATCH * SEQ, NIN = 17408, BRW = 3584;
constexpr float EPS = 1e-6f;
constexpr size_t MiB = 1u << 20;
constexpr size_t WS_PROJ = 0;
constexpr size_t WS_WIN  = 544 * MiB;
constexpr size_t WS_WBR  = 612 * MiB;
constexpr size_t WS_WOUT = 626 * MiB;
constexpr size_t WS_WKV  = 634 * MiB;
constexpr size_t WS_PW   = 638 * MiB;
constexpr size_t WS_LW   = 638 * MiB + 512 * 1024;
constexpr size_t WS_MEMN = 639 * MiB;
constexpr size_t WS_MK   = 641 * MiB;
constexpr size_t WS_VT   = 641 * MiB + 512 * 1024;
constexpr size_t WS_AGG  = 642 * MiB;
constexpr size_t WS_XN   = 644 * MiB;
constexpr size_t WS_X1   = 708 * MiB;
constexpr size_t WS_BR   = 836 * MiB;
constexpr size_t WS_QKVC = 948 * MiB;
constexpr size_t WS_MISC = 1044 * MiB;
constexpr size_t WS_END  = 1045 * MiB;
constexpr int LDS_BYTES = 147456;
#ifndef MK_MULTI
#define MK_MULTI 0
#endif
#ifndef DBL
#define DBL 0
#endif
#define PH(k) for (int rep_ = 0; rep_ < (((DBL) >> (k)) & 1) + 1; ++rep_) if constexpr (((PHM) >> (k)) & 1)
constexpr size_t WS_BAR = WS_MISC + 65536;
constexpr int MISC_OFF = 131072 + 512;
#define GSYNC() do { if constexpr (((PHM) & ((PHM) - 1)) != 0) { XcdBarrier xb_; xb_.bar = (unsigned*)((unsigned char*)(uintptr_t)karg64(168) + WS_BAR); xb_.x = xb_xcc_id(); \
    xb_.st = (volatile LAS unsigned*)(ldsl + MISC_OFF); xcd_barrier(xb_, MK_TID() == 0); if constexpr (((DBL) >> 15) & 1) { xcd_barrier(xb_, MK_TID() == 0); } } } while (0)
#ifndef DIAG
#define DIAG 0
#endif
#if DIAG
#define TS_OFF (WS_MISC + 131072)
#define STAMP(k) do { unsigned long long* tsp_ = (unsigned long long*)((unsigned char*)(uintptr_t)karg64(168) + TS_OFF); if (blockIdx.x == 0 && threadIdx.x == 0) tsp_[(k)] = __builtin_amdgcn_s_memrealtime(); } while (0)
#else
#define STAMP(k) do { } while (0)
#endif

#define LAS __attribute__((address_space(3)))
typedef unsigned short bf16;
typedef unsigned v4u __attribute__((ext_vector_type(4)));
typedef unsigned v2u __attribute__((ext_vector_type(2)));
typedef float f32x4 __attribute__((ext_vector_type(4)));
typedef float f32x2v __attribute__((ext_vector_type(2)));
typedef short bf16x8 __attribute__((ext_vector_type(8)));
typedef short s16x4 __attribute__((ext_vector_type(4)));
typedef float f32x16 __attribute__((ext_vector_type(16)));
#define LDS_WAIT() asm volatile("s_waitcnt lgkmcnt(0)" ::: "memory")
__device__ __forceinline__ unsigned f2bf(float f) { unsigned u = __builtin_bit_cast(unsigned, f); return (u + 0x7fffu + ((u >> 16) & 1u)) >> 16; }
__device__ __forceinline__ unsigned pk2(float lo, float hi) { return f2bf(lo) | (f2bf(hi) << 16); }
__device__ __forceinline__ float blo(unsigned w) { return __builtin_bit_cast(float, w << 16); }
__device__ __forceinline__ float bhi(unsigned w) { return __builtin_bit_cast(float, w & 0xffff0000u); }
__device__ __forceinline__ float shx(float v, int o, int lane) { return __builtin_bit_cast(float, __builtin_amdgcn_ds_bpermute((lane ^ o) << 2, __builtin_bit_cast(int, v))); }
__device__ __forceinline__ float wave_sum(float v, int lane) {
#pragma unroll
    for (int o = 1; o < 64; o <<= 1) v += shx(v, o, lane);
    return v;
}
__device__ __forceinline__ void p0_transpose_item(const float* W, int K, int N, bf16* WT, int row_off, LAS float* scr, int item, int lane) {
    const int nblk = N / 32, kb = item / nblk, nb = item % nblk, k0 = 64 * kb, n0 = 32 * nb;
    float wv[32];
#pragma unroll
    for (int i = 0; i < 32; ++i) wv[i] = W[(size_t)(k0 + 2 * i + (lane >> 5)) * N + n0 + (lane & 31)];
#pragma unroll
    for (int i = 0; i < 32; ++i) scr[(2 * i + (lane >> 5)) * 33 + (lane & 31)] = wv[i];
    LDS_WAIT(); asm volatile("" ::: "memory");
    const int c = lane & 7;
#pragma unroll
    for (int j = 0; j < 4; ++j) { const int n = (lane >> 3) + 8 * j; const LAS float* s = scr + (8 * c) * 33 + n;
        v4u o; o.x = pk2(s[0 * 33], s[1 * 33]); o.y = pk2(s[2 * 33], s[3 * 33]); o.z = pk2(s[4 * 33], s[5 * 33]); o.w = pk2(s[6 * 33], s[7 * 33]);
        *(v4u*)(WT + (size_t)(row_off + n0 + n) * K + k0 + 8 * c) = o; }
    LDS_WAIT(); asm volatile("" ::: "memory");
}
template <bool OUTF, bool INB = false> __device__ __forceinline__ void rms_rows(const void* x, const float* g, void* out, int first, int step, int nrows, int lane) {
    if (first >= nrows) return;
    f32x4 v[8];
    {
#pragma unroll
      for (int j = 0; j < 8; ++j) { if (INB) { const v2u w = ((const v2u*)((const bf16*)x + (size_t)first * 2048))[lane + 64 * j]; v[j] = (f32x4){blo(w.x), bhi(w.x), blo(w.y), bhi(w.y)}; } else v[j] = ((const f32x4*)((const float*)x + (size_t)first * 2048))[lane + 64 * j]; } }
    for (int m = first; m < nrows; m += step) {
        f32x4 nx[8]; const int mn = (m + step < nrows) ? m + step : m;
        {
#pragma unroll
          for (int j = 0; j < 8; ++j) { if (INB) { const v2u w = ((const v2u*)((const bf16*)x + (size_t)mn * 2048))[lane + 64 * j]; nx[j] = (f32x4){blo(w.x), bhi(w.x), blo(w.y), bhi(w.y)}; } else nx[j] = ((const f32x4*)((const float*)x + (size_t)mn * 2048))[lane + 64 * j]; } }
        float s = 0.f;
#pragma unroll
        for (int j = 0; j < 8; ++j) s += (v[j].x * v[j].x + v[j].y * v[j].y) + (v[j].z * v[j].z + v[j].w * v[j].w);
        const float rstd = 1.0f / sqrtf(wave_sum(s, lane) * (1.0f / 2048.0f) + EPS);
#pragma unroll
        for (int j = 0; j < 8; ++j) { const f32x4 gv = ((const f32x4*)g)[lane + 64 * j]; const f32x4 o = v[j] * rstd * gv;
            if (OUTF) ((f32x4*)((float*)out + (size_t)m * 2048))[lane + 64 * j] = o;
            else { v2u w; w.x = pk2(o.x, o.y); w.y = pk2(o.z, o.w); ((v2u*)((bf16*)out + (size_t)m * 2048))[lane + 64 * j] = w; } }
#pragma unroll
        for (int j = 0; j < 8; ++j) v[j] = nx[j];
    }
}

__device__ __forceinline__ void small_nt_tile(const bf16* A, const bf16* B, bf16* O, int ti, int tj, int lane) {
    const int q = lane & 31, hi = lane >> 5;
    const bf16* ap = A + (size_t)(ti * 32 + q) * 2048 + hi * 8; const bf16* bp = B + (size_t)(tj * 32 + q) * 2048 + hi * 8;
    f32x16 acc = f32x16{};
#pragma unroll 8
    for (int ks = 0; ks < 128; ++ks) { const bf16x8 af = *(const bf16x8*)(ap + ks * 16), bf = *(const bf16x8*)(bp + ks * 16); acc = __builtin_amdgcn_mfma_f32_32x32x16_bf16(af, bf, acc, 0, 0, 0); }
#pragma unroll
    for (int r = 0; r < 16; ++r) { const int i = (r & 3) + 8 * (r >> 2) + 4 * hi; O[(size_t)(ti * 32 + i) * 512 + tj * 32 + q] = (bf16)f2bf(acc[r]); }
}
__device__ __forceinline__ void memattn_unit(const bf16* PROJ, const bf16* MK, const bf16* VT, bf16* BR, int b, int hm, int rb, int lane) {
    const int q = lane & 31, hi = lane >> 5;
    const size_t row = (size_t)b * SEQ + (size_t)rb * 32 + q;
    bf16x8 qf[8];
#pragma unroll
    for (int d0 = 0; d0 < 8; ++d0) qf[d0] = *(const bf16x8*)(PROJ + row * NIN + 5120 + hm * 128 + d0 * 16 + hi * 8);
    const f32x16 zz = f32x16{};
    f32x16 sc[8];
#pragma unroll
    for (int kb = 0; kb < 8; ++kb) { sc[kb] = zz;
        const bf16* kp = MK + (size_t)(b * 256 + kb * 32 + q) * 512 + hm * 128 + hi * 8;
#pragma unroll
        for (int d0 = 0; d0 < 8; ++d0) { const bf16x8 kf = *(const bf16x8*)(kp + d0 * 16); sc[kb] = __builtin_amdgcn_mfma_f32_32x32x16_bf16(kf, qf[d0], sc[kb], 0, 0, 0); }
        __builtin_amdgcn_sched_barrier(0); }
    float mx = -INFINITY;
#pragma unroll
    for (int kb = 0; kb < 8; ++kb)
#pragma unroll
        for (int r = 0; r < 16; ++r) mx = fmaxf(mx, sc[kb][r]);
    mx = fmaxf(mx, shx(mx, 32, lane));
    const float cs = 0.08838834764831845f * 1.4426950408889634f; float l = 0.f;
#pragma unroll
    for (int kb = 0; kb < 8; ++kb)
#pragma unroll
        for (int r = 0; r < 16; ++r) { const float p = __builtin_amdgcn_exp2f((sc[kb][r] - mx) * cs); sc[kb][r] = p; l += p; }
    l += shx(l, 32, lane);
    const float inv = 1.0f / l;
    v4u pk[8][2];
#pragma unroll
    for (int kb = 0; kb < 8; ++kb)
#pragma unroll
        for (int s = 0; s < 2; ++s) {
            pk[kb][s].x = pk2(sc[kb][8 * s + 0] * inv, sc[kb][8 * s + 1] * inv); pk[kb][s].y = pk2(sc[kb][8 * s + 2] * inv, sc[kb][8 * s + 3] * inv);
            pk[kb][s].z = pk2(sc[kb][8 * s + 4] * inv, sc[kb][8 * s + 5] * inv); pk[kb][s].w = pk2(sc[kb][8 * s + 6] * inv, sc[kb][8 * s + 7] * inv); }
#pragma unroll
    for (int kb = 0; kb < 8; ++kb) asm volatile("" : "+v"(pk[kb][0]), "+v"(pk[kb][1]));
    f32x16 o[4]; o[0] = zz; o[1] = zz; o[2] = zz; o[3] = zz;
#pragma unroll
    for (int kb = 0; kb < 8; ++kb)
#pragma unroll
        for (int s = 0; s < 2; ++s) {
            const bf16x8 pb = __builtin_bit_cast(bf16x8, pk[kb][s]);
#pragma unroll
            for (int db = 0; db < 4; ++db) { const bf16* vp = VT + (size_t)(hm * 128 + db * 32 + q) * 512 + b * 256 + kb * 32 + 16 * s + 4 * hi;
                const s16x4 lo = *(const s16x4*)vp, hh = *(const s16x4*)(vp + 8);
                const bf16x8 va = (bf16x8){lo[0], lo[1], lo[2], lo[3], hh[0], hh[1], hh[2], hh[3]};
                o[db] = __builtin_amdgcn_mfma_f32_32x32x16_bf16(va, pb, o[db], 0, 0, 0); }
            __builtin_amdgcn_sched_barrier(0); }
    v2u gwv[4][4];
#pragma unroll
    for (int db = 0; db < 4; ++db)
#pragma unroll
        for (int g4 = 0; g4 < 4; ++g4) gwv[db][g4] = *(const v2u*)(PROJ + row * NIN + 5632 + 3072 + hm * 128 + db * 32 + g4 * 8 + 4 * hi);
#pragma unroll
    for (int db = 0; db < 4; ++db)
#pragma unroll
        for (int g4 = 0; g4 < 4; ++g4) { const int d = hm * 128 + db * 32 + g4 * 8 + 4 * hi;
            const v2u gw = gwv[db][g4];
            v2u w; w.x = pk2(o[db][4 * g4 + 0] * blo(gw.x), o[db][4 * g4 + 1] * bhi(gw.x)); w.y = pk2(o[db][4 * g4 + 2] * blo(gw.y), o[db][4 * g4 + 3] * bhi(gw.y));
            *(v2u*)(BR + row * BRW + 3072 + d) = w; }
}

__device__ __forceinline__ void memattn_stage(const bf16* MK, const bf16* VT, LAS unsigned char* lds, int b, int hm, int tid) {
#pragma unroll
    for (int i = 0; i < 8; ++i) { const int j = tid + 512 * i, key = j >> 4, c = j & 15;
        const v4u v = *(const v4u*)(MK + (size_t)(b * 256 + key) * 512 + hm * 128 + c * 8);
        *(LAS v4u*)(lds + key * 256 + ((c ^ (key & 15)) << 4)) = v; }
#pragma unroll
    for (int i = 0; i < 8; ++i) { const int j = tid + 512 * i, d = j >> 5, c16 = j & 31;
        const v4u v = *(const v4u*)(VT + (size_t)(hm * 128 + d) * 512 + b * 256 + c16 * 8);
        const int p0 = (2 * c16) ^ (d & 31); v2u lo; lo.x = v.x; lo.y = v.y; v2u hi; hi.x = v.z; hi.y = v.w;
        *(LAS v2u*)(lds + 65536 + d * 512 + p0 * 8) = lo; *(LAS v2u*)(lds + 65536 + d * 512 + (p0 ^ 1) * 8) = hi; }
}
__device__ __forceinline__ void memattn_unit_lds(const bf16* PROJ, LAS unsigned char* lds, bf16* BR, int b, int hm, int rb, int lane) {
    const int q = lane & 31, hi = lane >> 5;
    const size_t row = (size_t)b * SEQ + (size_t)rb * 32 + q;
    bf16x8 qf[8];
#pragma unroll
    for (int d0 = 0; d0 < 8; ++d0) qf[d0] = *(const bf16x8*)(PROJ + row * NIN + 5120 + hm * 128 + d0 * 16 + hi * 8);
    const f32x16 zz = f32x16{};
    f32x16 sc[8];
#pragma unroll
    for (int kb = 0; kb < 8; ++kb) { sc[kb] = zz;
        LAS unsigned char* kp = lds + (kb * 32 + q) * 256;
#pragma unroll
        for (int d0 = 0; d0 < 8; ++d0) { const bf16x8 kf = *(LAS bf16x8*)(kp + (((2 * d0 + hi) ^ (q & 15)) << 4)); sc[kb] = __builtin_amdgcn_mfma_f32_32x32x16_bf16(kf, qf[d0], sc[kb], 0, 0, 0); }
        __builtin_amdgcn_sched_barrier(0); }
    float mx = -INFINITY;
#pragma unroll
    for (int kb = 0; kb < 8; ++kb)
#pragma unroll
        for (int r = 0; r < 16; ++r) mx = fmaxf(mx, sc[kb][r]);
    mx = fmaxf(mx, shx(mx, 32, lane));
    const float cs = 0.08838834764831845f * 1.4426950408889634f; float l = 0.f;
#pragma unroll
    for (int kb = 0; kb < 8; ++kb)
#pragma unroll
        for (int r = 0; r < 16; ++r) { const float p = __builtin_amdgcn_exp2f((sc[kb][r] - mx) * cs); sc[kb][r] = p; l += p; }
    l += shx(l, 32, lane);
    const float inv = 1.0f / l;
    v4u pk[8][2];
#pragma unroll
    for (int kb = 0; kb < 8; ++kb)
#pragma unroll
        for (int s = 0; s < 2; ++s) {
            pk[kb][s].x = pk2(sc[kb][8 * s + 0] * inv, sc[kb][8 * s + 1] * inv); pk[kb][s].y = pk2(sc[kb][8 * s + 2] * inv, sc[kb][8 * s + 3] * inv);
            pk[kb][s].z = pk2(sc[kb][8 * s + 4] * inv, sc[kb][8 * s + 5] * inv); pk[kb][s].w = pk2(sc[kb][8 * s + 6] * inv, sc[kb][8 * s + 7] * inv); }
#pragma unroll
    for (int kb = 0; kb < 8; ++kb) asm volatile("" : "+v"(pk[kb][0]), "+v"(pk[kb][1]));
    f32x16 o[4]; o[0] = zz; o[1] = zz; o[2] = zz; o[3] = zz;
#pragma unroll
    for (int kb = 0; kb < 8; ++kb)
#pragma unroll
        for (int s = 0; s < 2; ++s) {
            const bf16x8 pb = __builtin_bit_cast(bf16x8, pk[kb][s]); const int g0 = kb * 8 + 4 * s + hi;
#pragma unroll
            for (int db = 0; db < 4; ++db) { LAS unsigned char* vp = lds + 65536 + (db * 32 + q) * 512;
                const s16x4 lo = *(LAS s16x4*)(vp + ((g0 ^ q) << 3)), hh = *(LAS s16x4*)(vp + (((g0 + 2) ^ q) << 3));
                const bf16x8 va = (bf16x8){lo[0], lo[1], lo[2], lo[3], hh[0], hh[1], hh[2], hh[3]};
                o[db] = __builtin_amdgcn_mfma_f32_32x32x16_bf16(va, pb, o[db], 0, 0, 0); }
            __builtin_amdgcn_sched_barrier(0); }
    v2u gwv[4][4];
#pragma unroll
    for (int db = 0; db < 4; ++db)
#pragma unroll
        for (int g4 = 0; g4 < 4; ++g4) gwv[db][g4] = *(const v2u*)(PROJ + row * NIN + 5632 + 3072 + hm * 128 + db * 32 + g4 * 8 + 4 * hi);
#pragma unroll
    for (int db = 0; db < 4; ++db)
#pragma unroll
        for (int g4 = 0; g4 < 4; ++g4) { const int d = hm * 128 + db * 32 + g4 * 8 + 4 * hi;
            const v2u gw = gwv[db][g4];
            v2u w; w.x = pk2(o[db][4 * g4 + 0] * blo(gw.x), o[db][4 * g4 + 1] * bhi(gw.x)); w.y = pk2(o[db][4 * g4 + 2] * blo(gw.y), o[db][4 * g4 + 3] * bhi(gw.y));
            *(v2u*)(BR + row * BRW + 3072 + d) = w; }
}
#define GAS __attribute__((address_space(1)))
#define RLX_AGENT __ATOMIC_RELAXED, __HIP_MEMORY_SCOPE_AGENT
#define XB_TMO      128
#define XB_XCNT(j)  (256  + 64 * (j))
#define XB_XSUB(j)  (1280 + 64 * (j))
#define XB_XGEN(j)  (2304 + 64 * (j))
#define XB_TOP      3328
#define XB_TOPGEN   3392
#define XCD_BAR_WORDS 3456
#define XB_SPIN_CAP (1u << 23)

__device__ __forceinline__ unsigned xb_ld(unsigned* p)              { return __hip_atomic_load(p, __ATOMIC_RELAXED, __HIP_MEMORY_SCOPE_AGENT); }
__device__ __forceinline__ unsigned xb_add(unsigned* p, unsigned v) { return __hip_atomic_fetch_add(p, v, __ATOMIC_RELAXED, __HIP_MEMORY_SCOPE_AGENT); }
__device__ __forceinline__ unsigned xb_xcc_id() { return (unsigned)__builtin_amdgcn_s_getreg((3 << 11) | 20) & 0xFu; }
#define XB_SPIN(cond, bar) do { unsigned _sp = 0; while (cond) { __builtin_amdgcn_s_sleep(1); \
    if ((++_sp & 255u) == 0u) { if (xb_ld(&(bar)[XB_TMO])) break; if (_sp > XB_SPIN_CAP) { atomicAdd(&(bar)[XB_TMO], 1u); break; } } } } while (0)

struct XcdBarrier {
    unsigned* bar; unsigned x;
    volatile LAS unsigned* st;
};

__device__ __forceinline__ XcdBarrier xcd_barrier_post(unsigned* bar, volatile LAS unsigned* st) {
    XcdBarrier b; b.bar = bar; b.x = xb_xcc_id(); b.st = st;
    if (threadIdx.x == 0)     (void)xb_add(&bar[XB_XCNT(b.x)], 1u);
    return b;
}
__device__ __forceinline__ void xcd_barrier_complete(unsigned* bar, unsigned x, unsigned& nloc, unsigned& nx) {
    const unsigned G = gridDim.x * gridDim.y * gridDim.z;
    unsigned sum, cnt, mine, sp = 0u;
    for (;;) {
        sum = 0u; cnt = 0u; mine = 0u;
#pragma unroll
        for (unsigned j = 0; j < 16; ++j) { const unsigned c = xb_ld(&bar[XB_XCNT(j)]); sum += c; cnt += (c > 0u) ? 1u : 0u; mine = (j == x) ? c : mine; }
        if (sum == G) break;
        __builtin_amdgcn_s_sleep(1);
        if ((++sp & 255u) == 0u) { if (xb_ld(&bar[XB_TMO])) break; if (sp > XB_SPIN_CAP) { atomicAdd(&bar[XB_TMO], 1u); break; } }
    }
    nloc = mine > 0u ? mine : 1u; nx = cnt > 0u ? cnt : 1u;
}

__device__ __forceinline__ void xcd_barrier(const XcdBarrier& b, const bool leader) {
    asm volatile("s_waitcnt vmcnt(0)" ::: "memory");
    __syncthreads();
    if (leader) {
        unsigned* bar = b.bar;
        __builtin_amdgcn_s_waitcnt(0);
        unsigned nloc = b.st[0], nx = b.st[1];
        if (nloc == 0u) { xcd_barrier_complete(bar, b.x, nloc, nx); b.st[0] = nloc; b.st[1] = nx; }
        const unsigned old = xb_add(&bar[XB_XSUB(b.x)], 1u);
        const unsigned gen = old / nloc;
        if (old + 1u == (gen + 1u) * nloc) {
            __builtin_amdgcn_fence(__ATOMIC_RELEASE, "agent");
            asm volatile("s_waitcnt vmcnt(0)" ::: "memory");
            const unsigned og = xb_add(&bar[XB_TOP], 1u);
            const unsigned tg = og / nx;
            if (og + 1u == (tg + 1u) * nx) xb_add(&bar[XB_TOPGEN], 1u);
            else XB_SPIN(xb_ld(&bar[XB_TOPGEN]) == tg, bar);
            __builtin_amdgcn_fence(__ATOMIC_ACQUIRE, "agent");
            xb_add(&bar[XB_XGEN(b.x)], 1u);
            asm volatile("s_waitcnt vmcnt(0)" ::: "memory");
        } else {
            XB_SPIN(xb_ld(&bar[XB_XGEN(b.x)]) == gen, bar);
            __builtin_amdgcn_fence(__ATOMIC_ACQUIRE, "agent");
            asm volatile("s_waitcnt vmcnt(0)" ::: "memory");
        }
    }
    __syncthreads();
}
__device__ __forceinline__ int mk_lane() { unsigned z = 0u; asm volatile("v_mov_b32 %0, 0" : "=v"(z)); return (int)__builtin_amdgcn_mbcnt_hi(~0u, __builtin_amdgcn_mbcnt_lo(~0u, z)); }
struct Args { const float* in[20]; float* out; unsigned char* ws; };
#define CAS __attribute__((address_space(4)))
__device__ __forceinline__ unsigned long long karg64(int byte_off) {
    const CAS char* p = (const CAS char*)__builtin_amdgcn_kernarg_segment_ptr(); asm volatile("" : "+s"(p));
    return *(const CAS unsigned long long*)(p + byte_off);
}
__device__ __forceinline__ const float* getp(int k) { return (const float*)(uintptr_t)karg64(8 * k); }
template <int PHM> __device__ __forceinline__ void layer_body(unsigned char* lds, LAS unsigned char* ldsl, cg::grid_group& grid, const int l, const int wave_s) {
#define MK_TID() (wave_s * 64 + mk_lane())
#define PHASE_IDS() int tid = MK_TID(); asm volatile("" : "+v"(tid)); int G = gridDim.x, bx = blockIdx.x; asm volatile("" : "+s"(G), "+s"(bx)); \
    unsigned char* ws = (unsigned char*)(uintptr_t)karg64(168); float* outp = (float*)(uintptr_t)karg64(160); \
    const int vcu = (G % 8 == 0) ? (bx % 8) * (G / 8) + bx / 8 : bx, NGW = G * NWAVES, NGT = G * NWAVES * 64; \
    const int lane = tid & 63, wave = __builtin_amdgcn_readfirstlane(tid >> 6), gw = vcu * NWAVES + wave, gt = vcu * (NWAVES * 64) + tid; \
    bf16* PROJ = (bf16*)(ws + WS_PROJ); bf16* WIN = (bf16*)(ws + WS_WIN); bf16* WBR = (bf16*)(ws + WS_WBR); bf16* WOUT = (bf16*)(ws + WS_WOUT); bf16* WKV = (bf16*)(ws + WS_WKV); \
    bf16* PW = (bf16*)(ws + WS_PW); bf16* LW = (bf16*)(ws + WS_LW); bf16* MEMN = (bf16*)(ws + WS_MEMN); bf16* MK = (bf16*)(ws + WS_MK); bf16* VT = (bf16*)(ws + WS_VT); \
    float* AGGP = (float*)(ws + WS_AGG); float* AGGH = AGGP + 256 * 1024; float* SPB = (float*)(ws + WS_MISC); \
    bf16* XN = (bf16*)(ws + WS_XN); bf16* AO = XN; bf16* MB = XN; bf16* X1 = (bf16*)(ws + WS_X1); bf16* BR = (bf16*)(ws + WS_BR); bf16* DP = (bf16*)((unsigned char*)outp + 64 * MiB); bf16* XC = (bf16*)((unsigned char*)outp + 96 * MiB); bf16* QKVC = (bf16*)(ws + WS_QKVC); \
    bf16* LAB = (bf16*)outp; bf16* UBB = LAB + (size_t)T * 1024; \
    (void)lane; (void)wave; (void)gw; (void)gt; (void)NGW; (void)NGT; (void)PROJ; (void)WIN; (void)WBR; (void)WOUT; (void)WKV; (void)PW; (void)LW; (void)MEMN; (void)MK; (void)VT; (void)AGGP; (void)AGGH; (void)SPB; \
    (void)XN; (void)AO; (void)MB; (void)X1; (void)BR; (void)DP; (void)XC; (void)LAB; (void)UBB; (void)QKVC
#define GETP(k) getp(k)

        const float lambda_init = (l == 0) ? 0.2f : 0.35550906759f;

        PH(0) { PHASE_IDS();
            LAS float* scr = (LAS float*)(ldsl + wave * 16384);
            const float* mem = GETP(1);
            const float* norm_g = GETP(2) + l * 2048; const float* w_in = GETP(3) + (size_t)l * 2048 * NIN; const float* pool_w = GETP(6) + (size_t)l * 4 * 65536;
            const float* lru_wa = GETP(10) + (size_t)l * 8 * 16384; const float* lru_wx = GETP(12) + (size_t)l * 8 * 16384; const float* lru_lam = GETP(14) + l * 1024;
            const float* mem_g = GETP(15) + l * 2048; const float* w_kv = GETP(16) + (size_t)l * 2048 * 1024; const float* w_br = GETP(17) + (size_t)l * BRW * 2048; const float* w_out = GETP(18) + (size_t)l * 2048 * 2048;
            constexpr int I_IN = 32 * 544, I_BR = 56 * 64, I_OUT = 32 * 64, I_KV = 32 * 32, I_PW = 4 * 32, I_LW = 8 * 8;
            constexpr int NITEMS = I_IN + I_BR + I_OUT + I_KV + I_PW + 2 * I_LW;
            for (int it = gw; it < NITEMS; it += NGW) {
                int r = it;
                if (r < I_IN) { p0_transpose_item(w_in, 2048, NIN, WIN, 0, scr, r, lane); continue; } r -= I_IN;
                if (r < I_BR) { p0_transpose_item(w_br, BRW, 2048, WBR, 0, scr, r, lane); continue; } r -= I_BR;
                if (r < I_OUT) { p0_transpose_item(w_out, 2048, 2048, WOUT, 0, scr, r, lane); continue; } r -= I_OUT;
                if (r < I_KV) { p0_transpose_item(w_kv, 2048, 1024, WKV, 0, scr, r, lane); continue; } r -= I_KV;
                if (r < I_PW) { const int g = r / 32; p0_transpose_item(pool_w + g * 65536, 256, 256, PW + g * 65536, 0, scr, r % 32, lane); continue; } r -= I_PW;
                if (r < I_LW) { const int g = r / 8; p0_transpose_item(lru_wa + g * 16384, 128, 128, LW + g * 32768, 0, scr, r % 8, lane); continue; } r -= I_LW;
                { const int g = r / 8; p0_transpose_item(lru_wx + g * 16384, 128, 128, LW + g * 32768, 128, scr, r % 8, lane); }
            }
            if (l == 0) rms_rows<false, false>(GETP(0), norm_g, XN, gw, NGW, T, lane); else rms_rows<false, true>(X1, norm_g, XN, gw, NGW, T, lane);
            rms_rows<false>(mem, mem_g, MEMN, gw, NGW, 512, lane);
            if (gt < 1024) SPB[gt] = -8.0f * 1.4426950408889634f * log1pf(__expf(-lru_lam[gt]));
        }
        GSYNC(); STAMP(l * 8 + 1);

        PH(1) { PHASE_IDS();
            pg8::Gemm g{XN, WIN, T, NIN, 2048, 2048, 2048, 1, 0, 0}; pg8::StaticOrder S; S.init(T, NIN, G, bx);
            pg8::EpiBf16Act E{PROJ, NIN, 1, QKVC};
            pg8::gemm_phase<pg8::EpiBf16Act, pg8::StaticOrder, true, true>(ldsl, g, S, E, tid);
        }
        GSYNC(); STAMP(l * 8 + 2);

        PH(2) { PHASE_IDS(); const float* conv_w = GETP(8) + l * 4096; const float* conv_b = GETP(9) + l * 1024;
        for (int u = gw; u < 2048; u += NGW) { if ((u & 3) == 0) { const int t2 = u >> 2, ti = (t2 >> 4) & 15, tj = t2 & 15;
            if (t2 < 256) small_nt_tile(MEMN, WKV, MK, ti, tj, lane); else small_nt_tile(WKV + (size_t)512 * 2048, MEMN, VT, ti, tj, lane); } }
        for (int it = gt; it < T * 128; it += NGT) {
            const int idx = it & 255, grp = __builtin_amdgcn_readfirstlane(idx >> 6), l6 = idx & 63, row = 2 * (it >> 8) + (l6 >> 5), ck = grp * 32 + (l6 & 31), t = row & (SEQ - 1), ch = ck * 8;
            v4u cv[4];
#pragma unroll
            for (int j = 0; j < 4; ++j) { const int back = 3 - j; const int bb = (back <= t) ? back : t; cv[j] = *(const v4u*)(PROJ + (size_t)row * NIN + 4096 + ch - (size_t)bb * NIN); }
            {
                const bf16* p = PROJ + (size_t)row * NIN + 3072 + ch; float s[8] = {0.f, 0.f, 0.f, 0.f, 0.f, 0.f, 0.f, 0.f}; float x0[8];
#define POOL_ACC(W) _Pragma("unroll") for (int u = 0; u < (W); ++u) { const int uu = (u <= t) ? u : t; const float wgt = (u <= t) ? 1.0f : 0.0f; const v4u v = *(const v4u*)(p - (size_t)uu * NIN); \
                    const float f[8] = {blo(v.x), bhi(v.x), blo(v.y), bhi(v.y), blo(v.z), bhi(v.z), blo(v.w), bhi(v.w)}; \
                    _Pragma("unroll") for (int j = 0; j < 8; ++j) { s[j] += wgt * f[j]; if (u == 0) x0[j] = f[j]; } }
                int w;
                if (grp == 0) { w = 2; POOL_ACC(2) } else if (grp == 1) { w = 4; POOL_ACC(4) } else if (grp == 2) { w = 8; POOL_ACC(8) } else { w = 16; POOL_ACC(16) }
#undef POOL_ACC
                const int cnt = (t + 1 < w) ? t + 1 : w; const float ic = 1.0f / (float)cnt; v4u o;
                o.x = pk2(s[0] * ic - x0[0], s[1] * ic - x0[1]); o.y = pk2(s[2] * ic - x0[2], s[3] * ic - x0[3]); o.z = pk2(s[4] * ic - x0[4], s[5] * ic - x0[5]); o.w = pk2(s[6] * ic - x0[6], s[7] * ic - x0[7]);
                *(v4u*)(DP + (size_t)row * 1024 + ch) = o;
            }
            {
                float s[8];
                { const f32x4 b0 = *(const f32x4*)(conv_b + ch), b1 = *(const f32x4*)(conv_b + ch + 4); s[0] = b0.x; s[1] = b0.y; s[2] = b0.z; s[3] = b0.w; s[4] = b1.x; s[5] = b1.y; s[6] = b1.z; s[7] = b1.w; }
#pragma unroll
                for (int j = 0; j < 4; ++j) { const int back = 3 - j; const float wgt = (back <= t) ? 1.0f : 0.0f; const v4u v = cv[j];
                    const f32x4 w0 = *(const f32x4*)(conv_w + j * 1024 + ch) * wgt, w1 = *(const f32x4*)(conv_w + j * 1024 + ch + 4) * wgt;
                    s[0] += w0.x * blo(v.x); s[1] += w0.y * bhi(v.x); s[2] += w0.z * blo(v.y); s[3] += w0.w * bhi(v.y); s[4] += w1.x * blo(v.z); s[5] += w1.y * bhi(v.z); s[6] += w1.z * blo(v.w); s[7] += w1.w * bhi(v.w); }
                v4u o; o.x = pk2(s[0], s[1]); o.y = pk2(s[2], s[3]); o.z = pk2(s[4], s[5]); o.w = pk2(s[6], s[7]);
                *(v4u*)(XC + (size_t)row * 1024 + ch) = o;
            }
        } }
        GSYNC(); STAMP(l * 8 + 3);

        PH(3) { int G = gridDim.x, bx = blockIdx.x; asm volatile("" : "+s"(G), "+s"(bx)); const int vcu = (G % 8 == 0) ? (bx % 8) * (G / 8) + bx / 8 : bx;
            unsigned char* ws = (unsigned char*)(uintptr_t)karg64(168); bf16* QKVC = (bf16*)(ws + WS_QKVC); bf16* AO = (bf16*)(ws + WS_XN);
            const attn_body::AttnTensors AT{(const attn_body::bf16*)QKVC, (const attn_body::bf16*)(QKVC + (size_t)T * 1024), (const attn_body::bf16*)(QKVC + (size_t)2 * T * 1024), (attn_body::bf16*)AO};
            attn_body::attn_phase<8>((char*)lds, AT, vcu, G, MK_TID());
            __syncthreads();
        }
        PH(9) { PHASE_IDS();
            pg8::Gemm gp{DP, PW, T, 256, 256, 1024, 256, 4, 512, 131072}; pg8::StaticOrder Sp; Sp.init(T, 256, G, bx, 4);
            pg8::EpiPool Ep{BR, GETP(7) + l * 1024, PROJ};
            pg8::gemm_phase<pg8::EpiPool, pg8::StaticOrder, true, true>(ldsl, gp, Sp, Ep, tid);
        }
        PH(10) { PHASE_IDS();
            pg8::Gemm gl{XC, LW, T, 256, 128, 1024, 128, 8, 256, 65536}; pg8::StaticOrder Sl; Sl.init(T, 256, G, bx, 8);
            pg8::EpiLru El{XC, GETP(11) + l * 1024, GETP(13) + l * 1024, SPB, LAB, UBB};
            pg8::gemm_phase<pg8::EpiLru, pg8::StaticOrder, true, true>(ldsl, gl, Sl, El, tid);
            { pg8::Unit uu;
              for (int i = 0; Sl.next(i, uu); ++i) { if (wave < 4) { const int sg = uu.pm * 4 + wave, ch = uu.pg * 128 + lane * 2; const size_t base = (size_t)sg * 64 * 1024 + ch;
                float h0 = 0.f, h1 = 0.f, L0 = 0.f, L1 = 0.f;
#pragma unroll 16
                for (int t = 0; t < 64; ++t) { const unsigned lw = *(const unsigned*)(LAB + base + (size_t)t * 1024), uw = *(const unsigned*)(UBB + base + (size_t)t * 1024);
                    const float l0 = blo(lw), l1 = bhi(lw); h0 = __builtin_amdgcn_exp2f(l0) * h0 + blo(uw); h1 = __builtin_amdgcn_exp2f(l1) * h1 + bhi(uw); L0 += l0; L1 += l1; }
                f32x2v pv; pv.x = __builtin_amdgcn_exp2f(L0); pv.y = __builtin_amdgcn_exp2f(L1); f32x2v hv; hv.x = h0; hv.y = h1;
                *(f32x2v*)(AGGP + sg * 1024 + ch) = pv; *(f32x2v*)(AGGH + sg * 1024 + ch) = hv; } } }
        }
        PH(11) { PHASE_IDS();
            if (G == 256) {
                const int u0 = vcu * 8, b = u0 >> 10, hm = (u0 >> 8) & 3;
                __syncthreads(); memattn_stage(MK, VT, ldsl, b, hm, tid); __syncthreads();
                memattn_unit_lds(PROJ, ldsl, BR, b, hm, (u0 & 255) + wave, lane);
                __syncthreads();
            } else
            for (int u = gw; u < 2048; u += NGW) memattn_unit(PROJ, MK, VT, BR, u >> 10, (u >> 8) & 3, u & 255, lane);
        }
        GSYNC(); STAMP(l * 8 + 4);

        PH(4) { PHASE_IDS();
            float lam; const float* lam_vecs = GETP(4) + l * 256; const float* subln_g = GETP(5) + l * 128;
            { const float p1 = lam_vecs[lane] * lam_vecs[64 + lane], p2 = lam_vecs[128 + lane] * lam_vecs[192 + lane];
              lam = __expf(wave_sum(p1, lane)) - __expf(wave_sum(p2, lane)) + lambda_init; }
            const float osc = 1.0f - lambda_init;
            for (int m0 = gw; m0 < T; m0 += 2 * NGW) {
                v4u va[2][2][2], vg[2][2];
#pragma unroll
                for (int rr = 0; rr < 2; ++rr) { const int m = (m0 + rr * NGW < T) ? m0 + rr * NGW : m0; const bf16* a0 = AO + (size_t)m * 2048 + lane * 16; const bf16* gp = PROJ + (size_t)m * NIN + 5632 + lane * 16;
#pragma unroll
                    for (int h2 = 0; h2 < 2; ++h2) { va[rr][h2][0] = *(const v4u*)(a0 + h2 * 8); va[rr][h2][1] = *(const v4u*)(a0 + 1024 + h2 * 8); vg[rr][h2] = *(const v4u*)(gp + h2 * 8); } }
#pragma unroll
                for (int rr = 0; rr < 2; ++rr) { const int m = m0 + rr * NGW; if (m < T) {
                    float d[16]; float ss = 0.f;
#pragma unroll
                    for (int h2 = 0; h2 < 2; ++h2) { const v4u v0 = va[rr][h2][0], v1 = va[rr][h2][1];
                        const float f0[8] = {blo(v0.x), bhi(v0.x), blo(v0.y), bhi(v0.y), blo(v0.z), bhi(v0.z), blo(v0.w), bhi(v0.w)};
                        const float f1[8] = {blo(v1.x), bhi(v1.x), blo(v1.y), bhi(v1.y), blo(v1.z), bhi(v1.z), blo(v1.w), bhi(v1.w)};
#pragma unroll
                        for (int j = 0; j < 8; ++j) { const float df = f0[j] - lam * f1[j]; d[h2 * 8 + j] = df; ss += df * df; } }
                    ss += shx(ss, 1, lane); ss += shx(ss, 2, lane); ss += shx(ss, 4, lane);
                    const float rstd = osc / sqrtf(ss * (1.0f / 128.0f) + EPS);
                    const int c0 = (lane & 7) * 16;
#pragma unroll
                    for (int h2 = 0; h2 < 2; ++h2) { const v4u gv = vg[rr][h2];
                        const float gf[8] = {blo(gv.x), bhi(gv.x), blo(gv.y), bhi(gv.y), blo(gv.z), bhi(gv.z), blo(gv.w), bhi(gv.w)};
                        const f32x4 s0 = *(const f32x4*)(subln_g + c0 + h2 * 8), s1 = *(const f32x4*)(subln_g + c0 + h2 * 8 + 4);
                        const float sg[8] = {s0.x, s0.y, s0.z, s0.w, s1.x, s1.y, s1.z, s1.w}; float y[8];
#pragma unroll
                        for (int j = 0; j < 8; ++j) y[j] = d[h2 * 8 + j] * rstd * sg[j] * gf[j];
                        v4u o; o.x = pk2(y[0], y[1]); o.y = pk2(y[2], y[3]); o.z = pk2(y[4], y[5]); o.w = pk2(y[6], y[7]);
                        *(v4u*)(BR + (size_t)m * BRW + lane * 16 + h2 * 8) = o; } } }
            }
        }
        PH(5) { PHASE_IDS(); for (int u = gw; u < 2048; u += NGW) { const int sg = u >> 3, ch = (u & 7) * 128 + lane * 2; const size_t base = (size_t)sg * 64 * 1024 + ch;
            float h0 = 0.f, h1 = 0.f;
#pragma unroll 16
            for (int s2 = sg & ~127; s2 < sg; ++s2) { const f32x2v p = *(const f32x2v*)(AGGP + s2 * 1024 + ch), hh = *(const f32x2v*)(AGGH + s2 * 1024 + ch); h0 = p.x * h0 + hh.x; h1 = p.y * h1 + hh.y; }
#pragma unroll 1
            for (int t0 = 0; t0 < 64; t0 += 16) {
                unsigned lw[16], uw[16], gg[16], ow[16];
#pragma unroll
                for (int i = 0; i < 16; ++i) { const size_t row = (size_t)sg * 64 + t0 + i; lw[i] = *(const unsigned*)(LAB + base + (size_t)(t0 + i) * 1024); uw[i] = *(const unsigned*)(UBB + base + (size_t)(t0 + i) * 1024);
                    gg[i] = *(const unsigned*)(PROJ + row * NIN + 5632 + 2048 + ch); }
#pragma unroll
                for (int i = 0; i < 16; ++i) { h0 = __builtin_amdgcn_exp2f(blo(lw[i])) * h0 + blo(uw[i]); h1 = __builtin_amdgcn_exp2f(bhi(lw[i])) * h1 + bhi(uw[i]); ow[i] = pk2(h0 * blo(gg[i]), h1 * bhi(gg[i])); }
#pragma unroll
                for (int i = 0; i < 16; ++i) { const size_t row = (size_t)sg * 64 + t0 + i; *(unsigned*)(BR + row * BRW + 2048 + ch) = ow[i]; }
            }
        } }
        GSYNC(); STAMP(l * 8 + 6);

        PH(6) { PHASE_IDS();
            pg8::Gemm g{BR, WBR, T, 2048, BRW, BRW, BRW, 1, 0, 0}; pg8::StaticOrder S; S.init(T, 2048, G, bx);
            pg8::EpiBranchFused E{PROJ + 9216, MB};
            pg8::gemm_phase<pg8::EpiBranchFused, pg8::StaticOrder, true, true>(ldsl, g, S, E, tid);
        }
        GSYNC(); STAMP(l * 8 + 7);

        PH(7) { PHASE_IDS();
            pg8::Gemm g{MB, WOUT, T, 2048, 2048, 2048, 2048, 1, 0, 0}; pg8::StaticOrder S; S.init(T, 2048, G, bx);
            if (l == 0) { pg8::EpiRes<false, true> E{GETP(0), X1, 2048}; pg8::gemm_phase<pg8::EpiRes<false, true>, pg8::StaticOrder, true, true>(ldsl, g, S, E, tid); }
            else { pg8::EpiRes<true, false> E{X1, outp, 2048}; pg8::gemm_phase<pg8::EpiRes<true, false>, pg8::StaticOrder, true, true>(ldsl, g, S, E, tid); }
        }
        GSYNC(); STAMP(l * 8 + 8);
}
template <int PHM> __global__ void __launch_bounds__(NWAVES * 64, 2) mk_fwd(Args args, int l0, int l1) {
    extern __shared__ __attribute__((aligned(16))) unsigned char lds[];
    cg::grid_group grid = cg::this_grid();
    LAS unsigned char* ldsl = (LAS unsigned char*)lds;
    (void)args; (void)ldsl;
    const int wave_s = __builtin_amdgcn_readfirstlane((int)threadIdx.x >> 6);
    if constexpr (((PHM) & ((PHM) - 1)) != 0) {
        if (threadIdx.x < 2) ((volatile LAS unsigned*)(ldsl + MISC_OFF))[threadIdx.x] = 0u;
        __syncthreads();
        (void)xcd_barrier_post((unsigned*)((unsigned char*)(uintptr_t)karg64(168) + WS_BAR), (volatile LAS unsigned*)(ldsl + MISC_OFF));
        if (l1 == 0x7fffffff) grid.sync();
    }
    STAMP(0);
    if constexpr (((PHM) & ((PHM) - 1)) != 0) { layer_body<PHM>(lds, ldsl, grid, 0, wave_s); layer_body<PHM>(lds, ldsl, grid, 1, wave_s); }
    else if constexpr (PHM != 0x100) layer_body<PHM>(lds, ldsl, grid, l0, wave_s);
    PH(8) { PHASE_IDS(); rms_rows<true>(outp, GETP(19), outp, gw, NGW, T, lane); }
#if DIAG
    GSYNC(); STAMP(17);
    GSYNC();
    {
        const unsigned long long* ts = (const unsigned long long*)((unsigned char*)(uintptr_t)karg64(168) + TS_OFF);
        float* o = (float*)(uintptr_t)karg64(160);
        int tid = threadIdx.x; asm volatile("" : "+v"(tid));
        const float A = (float)(unsigned)(ts[DIAG_A_HI] - ts[DIAG_A_LO]) * 0.01f, B = (float)(unsigned)(ts[DIAG_B_HI] - ts[DIAG_B_LO]) * 0.01f;
        const int n2 = (int)(B * 10000.0f) < 33000000 ? (int)(B * 10000.0f) : 33000000;
        const int gt_ = (int)blockIdx.x * 512 + tid, NT_ = (int)gridDim.x * 512;
        for (int i = gt_; i < n2; i += NT_) o[4096 + i] += 2.0f;
        if (gt_ == 0) o[0] = A;
    }
#endif
}

extern "C" void kernel_launch(void* const* d_in, const int* in_sizes, int n_in, void* d_out, int out_size, void* d_ws, size_t ws_size, hipStream_t stream) {
    static int grid = 0;
    if (grid == 0) {
        if (n_in != 20 || out_size != T * DMODEL || ws_size < WS_END) { fprintf(stderr, "kernel_launch: unexpected shapes / workspace (n_in %d out %d ws %zu, need %zu)\n", n_in, out_size, ws_size, (size_t)WS_END); grid = -1; return; }
        int dev = 0, cus = 0, per_cu = 0;
        if (hipGetDevice(&dev) != hipSuccess || hipDeviceGetAttribute(&cus, hipDeviceAttributeMultiprocessorCount, dev) != hipSuccess) { grid = -1; return; }
#if !MK_MULTI
        if (hipFuncSetAttribute((const void*)mk_fwd<0xfff>, hipFuncAttributeMaxDynamicSharedMemorySize, LDS_BYTES) != hipSuccess) { grid = -1; return; }
        if (hipOccupancyMaxActiveBlocksPerMultiprocessor(&per_cu, (const void*)mk_fwd<0xfff>, NWAVES * 64, LDS_BYTES) != hipSuccess || per_cu < 1) { fprintf(stderr, "kernel_launch: occupancy query says %d\n", per_cu); }
#endif
        (void)per_cu;
        (void)hipGetLastError();
        grid = cus;
    }
    if (grid < 0) return;
    Args a{};
    for (int i = 0; i < 20; ++i) a.in[i] = (const float*)d_in[i];
    a.out = (float*)d_out; a.ws = (unsigned char*)d_ws;
#if MK_MULTI
#define LAUNCH1(MASK, L0, L1) do { static bool once_##MASK = false; if (!once_##MASK) { (void)hipFuncSetAttribute((const void*)mk_fwd<MASK>, hipFuncAttributeMaxDynamicSharedMemorySize, LDS_BYTES); once_##MASK = true; } \
        hipLaunchKernelGGL(mk_fwd<MASK>, dim3(grid), dim3(NWAVES * 64), LDS_BYTES, stream, a, (L0), (L1)); } while (0)
    for (int l = 0; l < 2; ++l) {
        LAUNCH1(0x001, l, l + 1); LAUNCH1(0x002, l, l + 1); LAUNCH1(0x004, l, l + 1); LAUNCH1(0x008, l, l + 1); LAUNCH1(0x200, l, l + 1); LAUNCH1(0x400, l, l + 1); LAUNCH1(0x800, l, l + 1);
        LAUNCH1(0x010, l, l + 1); LAUNCH1(0x020, l, l + 1); LAUNCH1(0x040, l, l + 1); LAUNCH1(0x080, l, l + 1);
    }
    LAUNCH1(0x100, 0, 0);
#else
    if (hipMemsetAsync((char*)d_ws + WS_BAR, 0, 16384, stream) != hipSuccess) { fprintf(stderr, "kernel_launch: memset of the barrier words failed\n"); return; }
    int l0 = 0, l1 = 2;
    void* kargs[] = {&a, &l0, &l1};
    hipError_t e = hipLaunchCooperativeKernel((const void*)mk_fwd<0xfff>, dim3(grid), dim3(NWAVES * 64), kargs, LDS_BYTES, stream);
    if (e != hipSuccess) fprintf(stderr, "kernel_launch: cooperative launch failed: %s (grid %d)\n", hipGetErrorString(e), grid);
#endif
}
```

```cpp
#include <hip/hip_runtime.h>
#include <hip/hip_cooperative_groups.h>
#include <cstdio>
#include <cstdint>
namespace pg8 {
#define PG8_LAS __attribute__((address_space(3)))
typedef unsigned short bf16_t;
typedef short bf16x8 __attribute__((ext_vector_type(8)));
typedef float f32x4 __attribute__((ext_vector_type(4)));
typedef unsigned u32x4 __attribute__((ext_vector_type(4)));
constexpr int BM = 256, BK = 64, HALF = 128, HTB = HALF * BK * 2  , STAGE_BYTES = 8 * HTB, NXCD = 8, WGM = 8;

__host__ __device__ __forceinline__ int lds_byte(int r, int c) { const int st = (r >> 4) * 2 + (c >> 5), rr = r & 15, cc = c & 31, ob = rr * 64 + cc * 2; return st * 1024 + (ob ^ (((ob >> 9) & 1) << 5)); }
__host__ __device__ __forceinline__ void stage_rc(int b, int& R, int& C) { const int st = b / 1024, sb = b % 1024, swz = sb ^ (((sb >> 9) & 1) << 5); R = (st >> 1) * 16 + swz / 64; C = (st & 1) * 32 + (swz % 64) / 2; }
__host__ __device__ __forceinline__ int perm32(int rho) { const int n = rho >> 4, i = rho & 15; return 8 * (i >> 2) + 4 * n + (i & 3); }

struct Unit { int pm, pn, pg; };
struct Gemm { const bf16_t* A; const bf16_t* Bt; int M, N, K, lda, ldb, ng; size_t gA, gB; };

struct StaticOrder {
    int nM, nN, nwg, G, c, per;
    __host__ __device__ void init(int M, int N, int G_, int c_, int ng = 1) { nM = M / BM; nN = N / BM; per = nM * nN; nwg = per * ng; G = G_; c = c_; }
    __host__ __device__ bool next(int i, Unit& u) const {
        const long L = (long)i * G + c; if (L >= nwg) return false;
        int wgid = (int)L; { const int q = nwg / NXCD, r = nwg % NXCD, xcd = wgid % NXCD, off = wgid / NXCD; wgid = (xcd < r ? xcd * (q + 1) : r * (q + 1) + (xcd - r) * q) + off; }
        u.pg = wgid / per; wgid -= u.pg * per;
        const int nig = WGM * nN, gid = wgid / nig, fm = gid * WGM, gsz = (nM - fm) < WGM ? (nM - fm) : WGM;
        u.pm = fm + ((wgid % nig) % gsz); u.pn = (wgid % nig) / gsz; return true;
    }
    __device__ __forceinline__ void a_ready(const Unit&) const {}
    __device__ __forceinline__ void done(const Unit&) const {}
};

__device__ __forceinline__ unsigned cvt_pk_bf16(float lo, float hi) { unsigned r; asm volatile("v_cvt_pk_bf16_f32 %0, %1, %2" : "=v"(r) : "v"(lo), "v"(hi)); return r; }
typedef float f32x2 __attribute__((ext_vector_type(2)));
__device__ __forceinline__ f32x2 gelu_pk(f32x2 v) {
    const f32x2 av = __builtin_elementwise_abs(v), d = av * 0.2316418882f + 1.0f;
    f32x2 t; t.x = __builtin_amdgcn_rcpf(d.x); t.y = __builtin_amdgcn_rcpf(d.y);
    f32x2 q = t * 0.5307027145f + (-0.7265760135f); q = q * t + 0.7107068705f; q = q * t + (-0.142248368f); q = q * t + 0.127414796f; q = q * t;
    const f32x2 s = (v * v) * (-0.72134752044f);
    f32x2 e; e.x = __builtin_amdgcn_exp2f(s.x); e.y = __builtin_amdgcn_exp2f(s.y);
    const f32x2 m = v * (q * e), r = v - m;
    f32x2 o; o.x = v.x < 0.f ? m.x : r.x; o.y = v.y < 0.f ? m.y : r.y; return o;
}

template <class Epi, class Sched, bool ALIGN_EPI = false, bool SP2 = false>
__device__ __forceinline__ void gemm_phase(PG8_LAS unsigned char* lds, const Gemm g, const Sched& S, const Epi& E, int tid) {
    asm volatile("" : "+v"(tid));
    const int wid = __builtin_amdgcn_readfirstlane(tid >> 6), lane = tid & 63, wr = wid >> 2, wc = wid & 3, fr = lane & 15, fq = lane >> 4;
    int K = g.K; asm volatile("" : "+s"(K)); const int nt = K / BK;
    unsigned voffA[2], voffB[2];
#pragma unroll
    for (int i = 0; i < 2; ++i) { int R, C; stage_rc(tid * 16 + i * 8192, R, C); const int Rb = Epi::PERM ? ((R & ~31) + perm32(R & 31)) : R;
        voffA[i] = (unsigned)(R * g.lda + C) * 2u; voffB[i] = (unsigned)(Rb * g.ldb + C) * 2u; }
    const size_t kstep = (size_t)(BK * 2);
    const size_t hstepA = (size_t)HALF * g.lda * 2, hstepB = (size_t)HALF * g.ldb * 2;
    const size_t tstepA = 2 * hstepA, tstepB = 2 * hstepB;
    const unsigned ldsw = (unsigned)wid * 1024u;
    const int aoff = lds_byte(wr * 64 + fr, fq * 8), boff = lds_byte(wc * 32 + fr, fq * 8);
#define PG8_SA(b, h) (((b) * 2 + (h)) * HTB)
#define PG8_SB(b, h) ((4 + (b) * 2 + (h)) * HTB)
#define PG8_STAGE(bufoff, gbase, voff) do { _Pragma("unroll") for (int _i = 0; _i < 2; ++_i) \
        __builtin_amdgcn_global_load_lds((const unsigned*)((const char*)(gbase) + (voff)[_i]), (PG8_LAS unsigned*)(lds + (bufoff) + ldsw + _i * 8192), 16, 0, 0); } while (0)
#define PG8_LDA(dst, b, h) do { _Pragma("unroll") for (int m = 0; m < 4; ++m) _Pragma("unroll") for (int k = 0; k < 2; ++k) dst[m][k] = *(const PG8_LAS bf16x8*)(lds + PG8_SA(b, h) + aoff + m * 2048 + k * 1024); } while (0)
#define PG8_LDB(dst, b, h) do { _Pragma("unroll") for (int n = 0; n < 2; ++n) _Pragma("unroll") for (int k = 0; k < 2; ++k) dst[n][k] = *(const PG8_LAS bf16x8*)(lds + PG8_SB(b, h) + boff + n * 2048 + k * 1024); } while (0)
#define PG8_MMA(ai, bj, At, Bt) do { __builtin_amdgcn_s_setprio(1); _Pragma("unroll") for (int m = 0; m < 4; ++m) _Pragma("unroll") for (int n = 0; n < 2; ++n) _Pragma("unroll") for (int k = 0; k < 2; ++k) \
        acc[ai][bj][m][n] = __builtin_amdgcn_mfma_f32_16x16x32_bf16(Bt[n][k], At[m][k], acc[ai][bj][m][n], 0, 0, 0); __builtin_amdgcn_s_setprio(0); } while (0)
#define PG8_WAIT_V(n) asm volatile("s_waitcnt vmcnt(" #n ")" ::: "memory")
#define PG8_WAIT_L(n) asm volatile("s_waitcnt lgkmcnt(" #n ")" ::: "memory")
#define PG8_BAR __builtin_amdgcn_s_barrier()
#define PG8_SCHED __builtin_amdgcn_sched_barrier(0)
    Unit cur, nxt; int ui = 0;
    if (!S.next(0, cur)) return;
    f32x4 acc[2][2][4][2];
#pragma unroll
    for (int a = 0; a < 2; ++a)
#pragma unroll
        for (int b = 0; b < 2; ++b)
#pragma unroll
            for (int m = 0; m < 4; ++m)
#pragma unroll
                for (int n = 0; n < 2; ++n) acc[a][b][m][n] = (f32x4){0.f, 0.f, 0.f, 0.f};
    bf16x8 At[4][2], B0[2][2], B1[2][2];
    const char* cA = (const char*)g.A + (size_t)cur.pg * g.gA + (size_t)cur.pm * tstepA; const char* cB = (const char*)g.Bt + (size_t)cur.pg * g.gB + (size_t)cur.pn * tstepB;
    S.a_ready(cur);
    if constexpr (SP2) {
        PG8_STAGE(PG8_SB(0, 0), cB, voffB); PG8_STAGE(PG8_SB(0, 1), cB + hstepB, voffB); PG8_STAGE(PG8_SA(0, 0), cA, voffA); PG8_STAGE(PG8_SA(0, 1), cA + hstepA, voffA);
        if (wr == 1) PG8_BAR;
        PG8_WAIT_V(2); PG8_BAR;
        PG8_STAGE(PG8_SB(1, 0), cB + kstep, voffB); PG8_STAGE(PG8_SA(1, 0), cA + kstep, voffA); PG8_STAGE(PG8_SB(1, 1), cB + hstepB + kstep, voffB);
        PG8_WAIT_V(6); PG8_BAR;
    } else {
        PG8_STAGE(PG8_SB(0, 0), cB, voffB); PG8_STAGE(PG8_SA(0, 0), cA, voffA); PG8_STAGE(PG8_SB(0, 1), cB + hstepB, voffB); PG8_STAGE(PG8_SA(0, 1), cA + hstepA, voffA);
        if (wr == 1) PG8_BAR;
        PG8_WAIT_V(4); PG8_BAR;
        PG8_STAGE(PG8_SB(1, 0), cB + kstep, voffB); PG8_STAGE(PG8_SA(1, 0), cA + kstep, voffA); PG8_STAGE(PG8_SB(1, 1), cB + hstepB + kstep, voffB);
        PG8_WAIT_V(6); PG8_BAR;
    }
    for (;;) {
        const bool has_next = S.next(ui + 1, nxt);
        const char* nA = has_next ? (const char*)g.A + (size_t)nxt.pg * g.gA + (size_t)nxt.pm * tstepA : cA; const char* nB = has_next ? (const char*)g.Bt + (size_t)nxt.pg * g.gB + (size_t)nxt.pn * tstepB : cB;
#pragma unroll 1
        for (int t = 0; t < nt; t += 2) {
            if constexpr (Epi::HOOK) { if (t != 0 && (t & 15) == 0) E.hook(acc, cur, t >> 4, wr, wc, fr, fq); }
            const bool last = (t == nt - 2);
            const char* a1 = cA + (size_t)(t + 1) * kstep;
            const char* a2 = last ? nA : cA + (size_t)(t + 2) * kstep; const char* b2 = last ? nB : cB + (size_t)(t + 2) * kstep;
            const char* a3 = a2 + kstep; const char* b3 = b2 + kstep;
            if (last && has_next) S.a_ready(nxt);
            if constexpr (SP2) {
            PG8_LDB(B0, 0, 0); PG8_LDB(B1, 0, 1); PG8_SCHED; PG8_LDA(At, 0, 0); PG8_STAGE(PG8_SA(1, 1), a1 + hstepA, voffA);
            PG8_WAIT_V(8); PG8_WAIT_L(0); PG8_BAR; PG8_MMA(0, 0, At, B0); PG8_MMA(0, 1, At, B1); PG8_BAR; PG8_SCHED;
            PG8_LDA(At, 0, 1); PG8_STAGE(PG8_SB(0, 0), b2, voffB); PG8_STAGE(PG8_SB(0, 1), b2 + hstepB, voffB); PG8_STAGE(PG8_SA(0, 0), a2, voffA);
            PG8_WAIT_V(8); PG8_WAIT_L(0); PG8_BAR; PG8_MMA(1, 0, At, B0); PG8_MMA(1, 1, At, B1); PG8_BAR; PG8_SCHED;
            PG8_LDB(B0, 1, 0); PG8_LDB(B1, 1, 1); PG8_SCHED; PG8_LDA(At, 1, 0); PG8_STAGE(PG8_SA(0, 1), a2 + hstepA, voffA);
            PG8_WAIT_V(8); PG8_WAIT_L(0); PG8_BAR; PG8_MMA(0, 0, At, B0); PG8_MMA(0, 1, At, B1); PG8_BAR; PG8_SCHED;
            PG8_LDA(At, 1, 1); PG8_STAGE(PG8_SB(1, 0), b3, voffB); PG8_STAGE(PG8_SB(1, 1), b3 + hstepB, voffB); PG8_STAGE(PG8_SA(1, 0), a3, voffA);
            PG8_WAIT_V(8); PG8_WAIT_L(0); PG8_BAR; PG8_MMA(1, 0, At, B0); PG8_MMA(1, 1, At, B1); PG8_BAR; PG8_SCHED;
            } else {
            PG8_LDB(B0, 0, 0); PG8_SCHED; PG8_LDA(At, 0, 0); PG8_STAGE(PG8_SA(1, 1), a1 + hstepA, voffA);
            PG8_WAIT_L(8); PG8_BAR; PG8_WAIT_L(0); PG8_MMA(0, 0, At, B0); PG8_BAR; PG8_SCHED;
            PG8_LDB(B1, 0, 1); PG8_STAGE(PG8_SB(0, 0), b2, voffB);
            PG8_BAR; PG8_WAIT_L(0); PG8_MMA(0, 1, At, B1); PG8_BAR;
            PG8_LDA(At, 0, 1); PG8_STAGE(PG8_SA(0, 0), a2, voffA);
            PG8_BAR; PG8_WAIT_L(0); PG8_MMA(1, 0, At, B0); PG8_BAR; PG8_SCHED;
            PG8_STAGE(PG8_SB(0, 1), b2 + hstepB, voffB);
            PG8_WAIT_V(6); PG8_BAR; PG8_MMA(1, 1, At, B1); PG8_BAR;
            PG8_LDB(B0, 1, 0); PG8_SCHED; PG8_LDA(At, 1, 0); PG8_STAGE(PG8_SA(0, 1), a2 + hstepA, voffA);
            PG8_WAIT_L(8); PG8_BAR; PG8_WAIT_L(0); PG8_MMA(0, 0, At, B0); PG8_BAR; PG8_SCHED;
            PG8_LDB(B1, 1, 1); PG8_STAGE(PG8_SB(1, 0), b3, voffB);
            PG8_BAR; PG8_WAIT_L(0); PG8_MMA(0, 1, At, B1); PG8_BAR;
            PG8_LDA(At, 1, 1); PG8_STAGE(PG8_SA(1, 0), a3, voffA);
            PG8_BAR; PG8_WAIT_L(0); PG8_MMA(1, 0, At, B0); PG8_BAR; PG8_SCHED;
            PG8_STAGE(PG8_SB(1, 1), b3 + hstepB, voffB);
            PG8_WAIT_V(6); PG8_BAR; PG8_MMA(1, 1, At, B1); PG8_BAR;
            }
        }
        if constexpr (ALIGN_EPI) { if (wr == 0) PG8_BAR; }
        if constexpr (!Epi::AFTER_DRAIN) { E(acc, cur, wr, wc, fr, fq); S.done(cur); }
        if (!has_next) break;
#pragma unroll
        for (int a = 0; a < 2; ++a)
#pragma unroll
            for (int b = 0; b < 2; ++b)
#pragma unroll
                for (int m = 0; m < 4; ++m)
#pragma unroll
                    for (int n = 0; n < 2; ++n) acc[a][b][m][n] = (f32x4){0.f, 0.f, 0.f, 0.f};
        cur = nxt; cA = nA; cB = nB; ++ui;
        if constexpr (ALIGN_EPI) { if (wr == 1) PG8_BAR; }
    }
    PG8_WAIT_V(0);
    if constexpr (!ALIGN_EPI) { if (wr == 0) PG8_BAR; }
    PG8_BAR;
    if constexpr (Epi::AFTER_DRAIN) { E.fused(acc, cur, wr, wc, fr, fq, lds, wid, lane); S.done(cur); }
#undef PG8_SA
#undef PG8_SB
#undef PG8_STAGE
#undef PG8_LDA
#undef PG8_LDB
#undef PG8_MMA
#undef PG8_WAIT_V
#undef PG8_WAIT_L
#undef PG8_BAR
#undef PG8_SCHED
}
}
namespace pg8 {
typedef unsigned u32x2 __attribute__((ext_vector_type(2)));
constexpr float QSCALE = 0.125f * 1.4426950408889634f;
__device__ __forceinline__ float sigm(float v) { return __builtin_amdgcn_rcpf(1.0f + __builtin_amdgcn_exp2f(-1.4426950408889634f * v)); }
__device__ __forceinline__ float bf2f(unsigned short b) { return __builtin_bit_cast(float, (unsigned)b << 16); }
__device__ __forceinline__ float bflo(unsigned w) { return __builtin_bit_cast(float, w << 16); }
__device__ __forceinline__ float bfhi(unsigned w) { return __builtin_bit_cast(float, w & 0xffff0000u); }

struct EpiBf16Act {
    static constexpr bool PERM = true, AFTER_DRAIN = false, HOOK = false;
    bf16_t* O; int ldc; int kind; bf16_t* QKVC;
    __device__ __forceinline__ void operator()(const f32x4 (&acc)[2][2][4][2], const Unit& u, int wr, int wc, int fr, int fq) const {
        int mode = 0; float sc = 1.f;
        if (kind == 1) { if (u.pn < 4) sc = QSCALE; else if (u.pn >= 36) mode = 2; else if (u.pn >= 22) mode = 1;   }
        const int row0 = u.pm * BM + wr * 64 + fr, col0 = u.pn * BM + wc * 32 + 8 * fq;
        const bool compact = (kind == 1) && (u.pn < 12);
        const int csec = u.pn >> 2, ccol = (u.pn & 3) * BM + wc * 32 + 8 * fq;
#pragma unroll
        for (int ai = 0; ai < 2; ++ai)
#pragma unroll
            for (int m = 0; m < 4; ++m) { const int rr = row0 + ai * HALF + m * 16; bf16_t* rowp = O + (size_t)rr * ldc + col0;
                if (compact) rowp = QKVC + (size_t)csec * (16384u * 1024u) + ((size_t)((rr >> 13) * 16 + (ccol >> 6)) * 8192 + (rr & 8191)) * 64 + (ccol & 63);
#pragma unroll
                for (int bj = 0; bj < 2; ++bj) { f32x4 v0 = acc[ai][bj][m][0] * sc, v1 = acc[ai][bj][m][1] * sc;
                    if (mode != 0) {
#pragma unroll
                        for (int j = 0; j < 4; ++j) { const float s0 = sigm(v0[j]), s1 = sigm(v1[j]); v0[j] = (mode == 1) ? v0[j] * s0 : s0; v1[j] = (mode == 1) ? v1[j] * s1 : s1; } }
                    u32x4 w; w.x = cvt_pk_bf16(v0[0], v0[1]); w.y = cvt_pk_bf16(v0[2], v0[3]); w.z = cvt_pk_bf16(v1[0], v1[1]); w.w = cvt_pk_bf16(v1[2], v1[3]);
                    *(u32x4*)(rowp + (compact ? bj * (2 * 8192 * 64) : bj * HALF)) = w; } }
    }
};
template <bool BB, bool OB> struct EpiRes {
    static constexpr bool PERM = false, AFTER_DRAIN = false, HOOK = false;
    const void* base; void* out; int ldc;
    __device__ __forceinline__ void operator()(const f32x4 (&acc)[2][2][4][2], const Unit& u, int wr, int wc, int fr, int fq) const {
        const int col0 = u.pn * BM + wc * 32 + 4 * fq;
#pragma unroll
        for (int ai = 0; ai < 2; ++ai) { f32x4 b[4][2][2];
#pragma unroll
            for (int m = 0; m < 4; ++m) { const size_t off = (size_t)(u.pm * BM + ai * HALF + wr * 64 + m * 16 + fr) * ldc + col0;
#pragma unroll
                for (int bj = 0; bj < 2; ++bj)
#pragma unroll
                    for (int n = 0; n < 2; ++n) { const size_t o2 = off + bj * HALF + n * 16;
                        if (BB) { const u32x2 w = *(const u32x2*)((const bf16_t*)base + o2); b[m][bj][n] = (f32x4){bflo(w.x), bfhi(w.x), bflo(w.y), bfhi(w.y)}; }
                        else b[m][bj][n] = *(const f32x4*)((const float*)base + o2); } }
#pragma unroll
            for (int m = 0; m < 4; ++m) { const size_t off = (size_t)(u.pm * BM + ai * HALF + wr * 64 + m * 16 + fr) * ldc + col0;
#pragma unroll
                for (int bj = 0; bj < 2; ++bj)
#pragma unroll
                    for (int n = 0; n < 2; ++n) { const size_t o2 = off + bj * HALF + n * 16; const f32x4 v = b[m][bj][n] + acc[ai][bj][m][n];
                        if (OB) { u32x2 w; w.x = cvt_pk_bf16(v[0], v[1]); w.y = cvt_pk_bf16(v[2], v[3]); *(u32x2*)((bf16_t*)out + o2) = w; }
                        else *(f32x4*)((float*)out + o2) = v; } }
            asm volatile("" ::: "memory"); }
    }
};
struct EpiBranchFused {
    static constexpr bool PERM = false, AFTER_DRAIN = false, HOOK = true;
    const bf16_t* gate; bf16_t* ob;
    __device__ __forceinline__ void hook(f32x4 (&acc)[2][2][4][2], const Unit& u, int j, int wr, int wc, int fr, int fq) const {
        const unsigned col0 = (unsigned)(u.pn * BM + wc * 32 + 4 * fq); const char* gb = (const char*)gate;
#pragma unroll
        for (int ai = 0; ai < 2; ++ai) { u32x2 go[4][2][2], gn[4][2][2];
#pragma unroll
            for (int m = 0; m < 4; ++m) { const unsigned row = (unsigned)(u.pm * BM + ai * HALF + wr * 64 + m * 16 + fr);
#pragma unroll
                for (int bj = 0; bj < 2; ++bj)
#pragma unroll
                    for (int n = 0; n < 2; ++n) { const unsigned off = (row * 17408u + (unsigned)(j - 1) * 2048u + col0 + bj * HALF + n * 16) * 2u;
                        go[m][bj][n] = *(const u32x2*)(gb + (size_t)off); gn[m][bj][n] = *(const u32x2*)(gb + (size_t)(off + 4096u)); } }
#pragma unroll
            for (int m = 0; m < 4; ++m)
#pragma unroll
                for (int bj = 0; bj < 2; ++bj)
#pragma unroll
                    for (int n = 0; n < 2; ++n) { const u32x2 o = go[m][bj][n], g = gn[m][bj][n]; f32x4 v = acc[ai][bj][m][n];
                        v[0] *= bflo(o.x) * __builtin_amdgcn_rcpf(fmaxf(bflo(g.x), 1e-30f)); v[1] *= bfhi(o.x) * __builtin_amdgcn_rcpf(fmaxf(bfhi(g.x), 1e-30f));
                        v[2] *= bflo(o.y) * __builtin_amdgcn_rcpf(fmaxf(bflo(g.y), 1e-30f)); v[3] *= bfhi(o.y) * __builtin_amdgcn_rcpf(fmaxf(bfhi(g.y), 1e-30f));
                        acc[ai][bj][m][n] = v; }
            asm volatile("" ::: "memory"); }
    }
    __device__ __forceinline__ void operator()(const f32x4 (&acc)[2][2][4][2], const Unit& u, int wr, int wc, int fr, int fq) const {
        const unsigned col0 = (unsigned)(u.pn * BM + wc * 32 + 4 * fq); const char* gb = (const char*)gate; char* obp = (char*)ob;
#pragma unroll
        for (int ai = 0; ai < 2; ++ai) { u32x2 gw[4][2][2];
#pragma unroll
            for (int m = 0; m < 4; ++m) { const unsigned row = (unsigned)(u.pm * BM + ai * HALF + wr * 64 + m * 16 + fr);
#pragma unroll
                for (int bj = 0; bj < 2; ++bj)
#pragma unroll
                    for (int n = 0; n < 2; ++n) gw[m][bj][n] = *(const u32x2*)(gb + (size_t)((row * 17408u + 3u * 2048u + col0 + bj * HALF + n * 16) * 2u)); }
#pragma unroll
            for (int m = 0; m < 4; ++m) { const unsigned row = (unsigned)(u.pm * BM + ai * HALF + wr * 64 + m * 16 + fr);
#pragma unroll
                for (int bj = 0; bj < 2; ++bj)
#pragma unroll
                    for (int n = 0; n < 2; ++n) { const unsigned c = col0 + bj * HALF + n * 16; const u32x2 g = gw[m][bj][n]; const f32x4 v = acc[ai][bj][m][n];
                        u32x2 w; w.x = cvt_pk_bf16(v[0] * bflo(g.x), v[1] * bfhi(g.x)); w.y = cvt_pk_bf16(v[2] * bflo(g.y), v[3] * bfhi(g.y));
                        *(u32x2*)(obp + (size_t)((row * 2048u + c) * 2u)) = w; } }
            asm volatile("" ::: "memory"); }
    }
};
struct EpiPool {
    static constexpr bool PERM = true, AFTER_DRAIN = false, HOOK = false;
    bf16_t* BR; const float* scale; const bf16_t* PROJ;
    __device__ __forceinline__ void operator()(const f32x4 (&acc)[2][2][4][2], const Unit& u, int wr, int wc, int fr, int fq) const {
        const unsigned row0 = (unsigned)(u.pm * BM + wr * 64 + fr), ch0 = (unsigned)(u.pg * 256 + wc * 32 + 8 * fq);
        const char* gb = (const char*)PROJ; char* ob = (char*)BR;
#pragma unroll
        for (int bj = 0; bj < 2; ++bj) { const unsigned ch = ch0 + bj * HALF; const f32x4 s0 = *(const f32x4*)(scale + ch), s1 = *(const f32x4*)(scale + ch + 4);
            u32x4 gwv[2][4];
#pragma unroll
            for (int ai = 0; ai < 2; ++ai)
#pragma unroll
                for (int m = 0; m < 4; ++m) { const unsigned row = row0 + ai * HALF + m * 16; gwv[ai][m] = *(const u32x4*)(gb + (size_t)(row * 34816u + (6656u + ch) * 2u)); }
#pragma unroll
            for (int ai = 0; ai < 2; ++ai)
#pragma unroll
                for (int m = 0; m < 4; ++m) { const unsigned row = row0 + ai * HALF + m * 16; const u32x4 gw = gwv[ai][m];
                    f32x4 v0 = acc[ai][bj][m][0] * s0, v1 = acc[ai][bj][m][1] * s1;
                    u32x4 w; w.x = cvt_pk_bf16(v0[0] * bflo(gw.x), v0[1] * bfhi(gw.x)); w.y = cvt_pk_bf16(v0[2] * bflo(gw.y), v0[3] * bfhi(gw.y));
                    w.z = cvt_pk_bf16(v1[0] * bflo(gw.z), v1[1] * bfhi(gw.z)); w.w = cvt_pk_bf16(v1[2] * bflo(gw.w), v1[3] * bfhi(gw.w));
                    *(u32x4*)(ob + (size_t)(row * 7168u + (1024u + ch) * 2u)) = w; }
            asm volatile("" ::: "memory"); }
    }
};
struct EpiLru {
    static constexpr bool PERM = false, AFTER_DRAIN = false, HOOK = false;
    const bf16_t* XC; const float *ba, *bx, *lam; bf16_t *LA, *UB;
    __device__ __forceinline__ void operator()(const f32x4 (&acc)[2][2][4][2], const Unit& u, int wr, int wc, int fr, int fq) const {
        const char* xb = (const char*)XC; char* ab = (char*)LA; char* ub = (char*)UB;
#pragma unroll
        for (int n = 0; n < 2; ++n) { const unsigned ch = (unsigned)(u.pg * 128 + wc * 32 + n * 16 + 4 * fq);
            const f32x4 bav = *(const f32x4*)(ba + ch), bxv = *(const f32x4*)(bx + ch), sp = *(const f32x4*)(lam + ch);
            u32x2 xwv[2][4];
#pragma unroll
            for (int ai = 0; ai < 2; ++ai)
#pragma unroll
                for (int m = 0; m < 4; ++m) { const unsigned row = (unsigned)(u.pm * BM + ai * HALF + wr * 64 + m * 16 + fr); xwv[ai][m] = *(const u32x2*)(xb + (size_t)((row * 1024u + ch) * 2u)); }
#pragma unroll
            for (int ai = 0; ai < 2; ++ai)
#pragma unroll
                for (int m = 0; m < 4; ++m) { const unsigned row = (unsigned)(u.pm * BM + ai * HALF + wr * 64 + m * 16 + fr); const unsigned off = (row * 1024u + ch) * 2u;
                    const u32x2 xw = xwv[ai][m]; const float xc[4] = {bflo(xw.x), bfhi(xw.x), bflo(xw.y), bfhi(xw.y)};
                    const f32x4 rp = acc[ai][0][m][n] + bav, ip = acc[ai][1][m][n] + bxv;
                    u32x2 lw; lw.x = cvt_pk_bf16(sp[0] * sigm(rp[0]), sp[1] * sigm(rp[1])); lw.y = cvt_pk_bf16(sp[2] * sigm(rp[2]), sp[3] * sigm(rp[3]));
                    const float la[4] = {bflo(lw.x), bfhi(lw.x), bflo(lw.y), bfhi(lw.y)}; float uv[4];
#pragma unroll
                    for (int j = 0; j < 4; ++j) { const float ig = sigm(ip[j]); const float a = __builtin_amdgcn_exp2f(la[j]);
                        float mult = __builtin_sqrtf((1.0f - a) * (1.0f + a)); if ((row & 8191u) == 0u) mult = 1.0f;
                        uv[j] = mult * ig * xc[j]; }
                    u32x2 uw; uw.x = cvt_pk_bf16(uv[0], uv[1]); uw.y = cvt_pk_bf16(uv[2], uv[3]);
                    *(u32x2*)(ab + (size_t)off) = lw; *(u32x2*)(ub + (size_t)off) = uw; }
            asm volatile("" ::: "memory"); }
    }
};
}
#include <hip/hip_bf16.h>
#include <cmath>
namespace attn_body {
using bf16=__hip_bfloat16;
using bf16x8=__attribute__((ext_vector_type(8)))short;
using s16x4=__attribute__((ext_vector_type(4)))short;
using f32x16=__attribute__((ext_vector_type(16)))float;
using u32x4=__attribute__((ext_vector_type(4)))unsigned;
constexpr int BATCH=2,NHEAD=16,SEQ=8192,D=64,DM=NHEAD*D,QP=64,OP=2048;
constexpr int NW=8,QBLK=32,QB=QBLK*NW,KVBLK=64,NQB=SEQ/QB;
constexpr int ATTN_PITCH=DM, ATTN_UNIT_ROWS=QB;
__device__ __forceinline__ int crow(int r,int hi){return (r&3)+8*(r>>2)+4*hi;}
#define SBAR() __builtin_amdgcn_sched_barrier(0)
__device__ __forceinline__ void cmask(f32x16&p0,f32x16&p1,int jb,int qrel,int hi){
  const float NEG=-INFINITY; int dlt=qrel-64*jb-4*hi; asm volatile("":"+v"(dlt));
  #pragma unroll
  for(int r=0;r<16;++r){const int cr=(r&3)+8*(r>>2); if(cr>dlt)p0[r]=NEG; if(cr+32>dlt)p1[r]=NEG;}
}

constexpr int NSLOT=3, SLOTB=8192;
constexpr int LDS_K=0, LDS_V=NSLOT*SLOTB, LDS_WS=LDS_V+NSLOT*2*SLOTB, LDS_OST=LDS_WS+NW*64*4, LDS_BYTES=LDS_OST+NW*4096;
constexpr float C2=0.125f*1.4426950408889634f;
__device__ __forceinline__ void glds16(const void*gsrc,unsigned lds_dst){unsigned keep;
  asm volatile("s_mov_b32 %0, m0\n\ts_mov_b32 m0, %2\n\ts_nop 0\n\tglobal_load_lds_dwordx4 %1, off\n\ts_mov_b32 m0, %0":"=&s"(keep):"v"(gsrc),"s"(lds_dst):"memory");}
__device__ __forceinline__ float max3f(float a,float b,float c){float r;asm("v_max3_f32 %0, %1, %2, %3":"=v"(r):"v"(a),"v"(b),"v"(c));return r;}
__device__ __forceinline__ float max2f(float a,float b){float r;asm("v_max_f32_e32 %0, %1, %2":"=v"(r):"v"(a),"v"(b));return r;}
__device__ __forceinline__ float fadd_s(float a,float b){float r;asm("v_add_f32_e32 %0, %1, %2":"=v"(r):"v"(a),"v"(b));return r;}
__device__ __forceinline__ float fsub_s(float a,float b){float r;asm("v_sub_f32_e32 %0, %1, %2":"=v"(r):"v"(a),"v"(b));return r;}
typedef float f32x2_t __attribute__((ext_vector_type(2))); typedef __bf16 bf16x2_t __attribute__((ext_vector_type(2)));
__device__ __forceinline__ unsigned cvtpk_s(float lo,float hi){f32x2_t v={lo,hi};bf16x2_t b=__builtin_convertvector(v,bf16x2_t);return __builtin_bit_cast(unsigned,b);}
__device__ __forceinline__ void glds16s(const void*sbase,unsigned voff,unsigned lds_dst){unsigned keep;
  asm volatile("s_mov_b32 %0, m0\n\ts_mov_b32 m0, %3\n\ts_nop 0\n\tglobal_load_lds_dwordx4 %1, %2\n\ts_mov_b32 m0, %0":"=&s"(keep):"v"(voff),"s"(sbase),"s"(lds_dst):"memory");}
#define WAIT_BAR(N) asm volatile("s_waitcnt vmcnt(" #N ") lgkmcnt(0)\n\ts_barrier":::"memory")

__device__ __forceinline__ void qkt(f32x16&p0,f32x16&p1,const char*Kslot,const bf16x8*qr,const f32x16&negm,int r32,int hi){
  const char*kb=Kslot+hi*1024+r32*16;
  #pragma unroll
  for(int d0=0;d0<4;++d0){
    const bf16x8 b0=*reinterpret_cast<const bf16x8*>(kb+d0*2048);
    const bf16x8 b1=*reinterpret_cast<const bf16x8*>(kb+d0*2048+512);
    if(d0==0){p0=__builtin_amdgcn_mfma_f32_32x32x16_bf16(b0,qr[0],negm,0,0,0);p1=__builtin_amdgcn_mfma_f32_32x32x16_bf16(b1,qr[0],negm,0,0,0);}
    else{p0=__builtin_amdgcn_mfma_f32_32x32x16_bf16(b0,qr[d0],p0,0,0,0);p1=__builtin_amdgcn_mfma_f32_32x32x16_bf16(b1,qr[d0],p1,0,0,0);}}
}
typedef __attribute__((address_space(3))) const char* lds_cptr;
typedef short v4i16_t __attribute__((ext_vector_type(4)));
__device__ __forceinline__ void kload8(bf16x8*kf,lds_cptr kp){
  kf[0]=*(const __attribute__((address_space(3))) bf16x8*)(kp);      kf[1]=*(const __attribute__((address_space(3))) bf16x8*)(kp+512);
  kf[2]=*(const __attribute__((address_space(3))) bf16x8*)(kp+2048); kf[3]=*(const __attribute__((address_space(3))) bf16x8*)(kp+2560);
  kf[4]=*(const __attribute__((address_space(3))) bf16x8*)(kp+4096); kf[5]=*(const __attribute__((address_space(3))) bf16x8*)(kp+4608);
  kf[6]=*(const __attribute__((address_space(3))) bf16x8*)(kp+6144); kf[7]=*(const __attribute__((address_space(3))) bf16x8*)(kp+6656);
}
__device__ __forceinline__ void kload2(bf16x8*kf,lds_cptr kp,int j){ kf[2*j]=*(const __attribute__((address_space(3))) bf16x8*)(kp+j*2048); kf[2*j+1]=*(const __attribute__((address_space(3))) bf16x8*)(kp+j*2048+512); }
__device__ __forceinline__ s16x4 vtr(lds_cptr p){ return __builtin_bit_cast(s16x4,__builtin_amdgcn_ds_read_tr16_b64_v4i16((__attribute__((address_space(3))) v4i16_t*)p)); }
__device__ __forceinline__ float rowmax(const f32x16&p0,const f32x16&p1){
  float a=max3f(p0[0],p0[1],p1[0]),b=max3f(p0[2],p0[3],p1[1]);a=max3f(a,p1[2],p1[3]);
  #pragma unroll
  for(int r=4;r<16;r+=4){a=max3f(a,p0[r],p0[r+1]);b=max3f(b,p0[r+2],p0[r+3]);a=max3f(a,p1[r],p1[r+1]);b=max3f(b,p1[r+2],p1[r+3]);}
  const float m=max2f(a,b);
  auto rr=__builtin_amdgcn_permlane32_swap(__float_as_uint(m),__float_as_uint(m),false,false);
  return max2f(__uint_as_float(rr[0]),__uint_as_float(rr[1]));
}
__device__ __forceinline__ void pv(f32x16*o,int vb,bf16x8 pa0,bf16x8 pa1,bf16x8 pa2,bf16x8 pa3){
  #pragma unroll
  for(int d0=0;d0<2;++d0){s16x4 lo[4],hi[4];
    #pragma unroll
    for(int ks=0;ks<4;++ks){
      asm volatile("ds_read_b64_tr_b16 %0,%1 offset:%c2":"=&v"(lo[ks]):"v"(vb),"i"(d0*4096+ks*1024):"memory");
      asm volatile("ds_read_b64_tr_b16 %0,%1 offset:%c2":"=&v"(hi[ks]):"v"(vb),"i"(d0*4096+ks*1024+512):"memory");}
    asm volatile("s_waitcnt lgkmcnt(0)":::"memory");SBAR();
    #define PK(k) (bf16x8){lo[k][0],lo[k][1],lo[k][2],lo[k][3],hi[k][0],hi[k][1],hi[k][2],hi[k][3]}
    o[d0]=__builtin_amdgcn_mfma_f32_32x32x16_bf16(pa0,PK(0),o[d0],0,0,0);
    o[d0]=__builtin_amdgcn_mfma_f32_32x32x16_bf16(pa1,PK(1),o[d0],0,0,0);
    o[d0]=__builtin_amdgcn_mfma_f32_32x32x16_bf16(pa2,PK(2),o[d0],0,0,0);
    o[d0]=__builtin_amdgcn_mfma_f32_32x32x16_bf16(pa3,PK(3),o[d0],0,0,0);
    #undef PK
  }
}

#ifndef ATTN_STORE16
#define ATTN_STORE16(p,v) (*(u32x4*)(p)=(v))
#endif
template<int THRL> __device__ __forceinline__ void attn_unit(int b,int h,int vcol,int ocol,int qb,const bf16*Q,const bf16*__restrict__ K,const bf16*__restrict__ V,bf16*O,char*shm,const int tid){
  const int lane=tid&63,r32=lane&31,hi=lane>>5; const int wid=__builtin_amdgcn_readfirstlane(tid>>6);
  const long rowbase=(long)b*SEQ; const int q0=qb*QB;
  const bf16*Qw=Q+((long)(b*NHEAD+h)*SEQ+q0+wid*QBLK)*QP;
  const bf16*Kh=K+(long)(b*NHEAD+h)*SEQ*QP,*Vh=V+(long)(b*NHEAD+vcol)*SEQ*QP;
  const unsigned lds0=(unsigned)(uintptr_t)shm;
  float*wsf=(float*)(shm+LDS_WS)+wid*64;
  const unsigned koff=(unsigned)(lane*QP+wid*8)*2u;
  const unsigned voff=(unsigned)((16*(wid&3)+(lane>>2))*QP+(wid>>2)*32+(lane&3)*8)*2u;
  const unsigned kdst=lds0+LDS_K+wid*1024, vdst=lds0+LDS_V+wid*1024;
  #define DMA_K(t,slot) glds16s(Kh+(long)(t)*KVBLK*QP,koff,(unsigned)__builtin_amdgcn_readfirstlane(kdst+(slot)))
  #define DMA_V(t,slot) do{ glds16s(Vh+(long)(t)*KVBLK*QP,voff,(unsigned)__builtin_amdgcn_readfirstlane(vdst+2*(slot))); glds16s(Vh+(long)SEQ*QP+(long)(t)*KVBLK*QP,voff,(unsigned)__builtin_amdgcn_readfirstlane(vdst+2*(slot)+SLOTB)); }while(0)
  const char*Kbase=shm+LDS_K; bf16x8 kf[8];
  const lds_cptr shm3=(lds_cptr)shm; const lds_cptr kp0=shm3+LDS_K+hi*1024+r32*16; const lds_cptr vp0=shm3+LDS_V+((lane>>4)&1)*32+(lane&3)*8+(4*hi+((lane&15)>>2))*64;
  const int NT=(q0+QB)/KVBLK;
  DMA_K(0,0);DMA_V(0,0);DMA_K(1,SLOTB);
  bf16x8 qr[4];
  #pragma unroll
  for(int d0=0;d0<4;++d0)qr[d0]=*reinterpret_cast<const bf16x8*>(&Qw[(long)r32*QP+d0*16+hi*8]);
  float mhat=0.f,l_reg=0.f;f32x16 o[4];o[0]=f32x16{};o[1]=f32x16{};o[2]=f32x16{};o[3]=f32x16{};f32x16 negm=f32x16{};asm volatile("":"+v"(negm));
  const int qrel=wid*QBLK+r32;
  #define CMASK(P0,P1,t) do{int jb_=(t)-(NT-4); if(jb_>=0)cmask(P0,P1,jb_,qrel,hi);}while(0)
  bool resc=false;
  #define START(P0,P1) do{ const float rm=rowmax(P0,P1); resc=false; \
    { const float dl=rm; mhat=fadd_s(mhat,dl); \
      _Pragma("unroll") for(int r=0;r<16;++r){P0[r]=fsub_s(P0[r],dl);P1[r]=fsub_s(P1[r],dl);} \
      _Pragma("unroll") for(int r=0;r<16;++r)negm[r]=-mhat; asm volatile("":"+v"(negm)); } \
    _Pragma("unroll") for(int r=0;r<16;++r)P0[r]=__builtin_amdgcn_exp2f(P0[r]); }while(0)
  #define RESC() do{ if(resc){ asm volatile("s_waitcnt lgkmcnt(0)":::"memory"); \
      _Pragma("unroll") for(int d_=0;d_<4;++d_) _Pragma("unroll") for(int r=0;r<16;++r)o[d_][r]*=wsf[crow(r,hi)]; } }while(0)
  f32x16 pA0,pA1,pB0,pB1;
  int sl_prev=0,sl_cur=0,sl_next=SLOTB;
  #define ROT() do{sl_prev=sl_cur;sl_cur=sl_next;sl_next=(sl_next==(NSLOT-1)*SLOTB)?0:sl_next+SLOTB;}while(0)
  DMA_K(2,2*SLOTB);
  WAIT_BAR(3);
  qkt(pA0,pA1,Kbase,qr,negm,r32,hi);asm volatile("s_nop 15\n\ts_nop 7":"+v"(pA0),"+v"(pA1));CMASK(pA0,pA1,0);
  START(pA0,pA1);
  _Pragma("unroll") for(int r=0;r<16;++r)pA1[r]=__builtin_amdgcn_exp2f(pA1[r]);
  WAIT_BAR(0);
  DMA_K(3,0);DMA_V(1,SLOTB);
  ROT();
  kload8(kf,kp0+sl_cur);
  WAIT_BAR(3);
  s16x4 vlo[4],vhi[4]; u32x4 pw0,pw1,pw2,pw3;
  #define PKW(P,B) cvtpk_s(P[B],P[B+1])
  #define PAF(k) __builtin_bit_cast(bf16x8,pw##k)
  #define VFS(i) (bf16x8){vlo[i][0],vlo[i][1],vlo[i][2],vlo[i][3],vhi[i][0],vhi[i][1],vhi[i][2],vhi[i][3]}
  #define PIN(x) asm volatile("":"+v"(x))
  #define MX3(a,b,c) __builtin_fmaxf(__builtin_fmaxf((a),(b)),(c))
  #define GAPA(MF,A0,A1,A2,A3,W0,W1,PW) do{ MF; sacc+=A0; sacc+=A1; sacc+=A2; sacc+=A3; PIN(sacc); W0; W1; PIN(PW); SBAR(); }while(0)
  #define EX(v) __builtin_amdgcn_exp2f(v)
  #define GAPB(MF,X,B) do{ MF; X[B]=EX(X[B]); X[B+1]=EX(X[B+1]); X[B+2]=EX(X[B+2]); X[B+3]=EX(X[B+3]); PIN(X); SBAR(); }while(0)
  #define GAPB2(MF,X,B) do{ MF; X[B]=EX(X[B]); X[B+1]=EX(X[B+1]); PIN(X); SBAR(); }while(0)
  #define VRDX(s,h,i) do{ vlo[s]=vtr(vp_+((h)*SLOTB+((i)>>2)*4096+((i)&3)*1024)); vhi[s]=vtr(vp_+((h)*SLOTB+((i)>>2)*4096+((i)&3)*1024+512)); SBAR(); }while(0)
  #define VRD(i) do{ vlo[i]=vtr(vp_+(((i)>>2)*4096+((i)&3)*1024)); vhi[i]=vtr(vp_+(((i)>>2)*4096+((i)&3)*1024+512)); }while(0)
  #define KRD(G,j) do{ if(G){ kload2(kf,kp0+sl_next,j); SBAR(); } }while(0)
  #define STEP(C0,C1,P0,P1,t,GK,GV,GL) do{ SBAR(); \
    const lds_cptr vp_=vp0+2*sl_prev; \
    SBAR(); float sacc=(P0[0]+P0[1]); \
    GAPA(C0=__builtin_amdgcn_mfma_f32_32x32x16_bf16(kf[0],qr[0],negm,0,0,0), P0[2],P0[3],P0[4],P0[5],     pw0[0]=PKW(P0,0), pw0[1]=PKW(P0,2), pw0); \
    GAPA(C1=__builtin_amdgcn_mfma_f32_32x32x16_bf16(kf[1],qr[0],negm,0,0,0), P0[6],P0[7],P0[8],P0[9],     pw0[2]=PKW(P0,4), pw0[3]=PKW(P0,6), pw0); \
    GAPA(C0=__builtin_amdgcn_mfma_f32_32x32x16_bf16(kf[2],qr[1],C0,0,0,0),   P0[10],P0[11],P0[12],P0[13], pw1[0]=PKW(P0,8), pw1[1]=PKW(P0,10), pw1); \
    GAPA(C1=__builtin_amdgcn_mfma_f32_32x32x16_bf16(kf[3],qr[1],C1,0,0,0),   P0[14],P0[15],P1[0],P1[1],   pw1[2]=PKW(P0,12),pw1[3]=PKW(P0,14), pw1); \
    VRDX(0,0,0); GAPA(C0=__builtin_amdgcn_mfma_f32_32x32x16_bf16(kf[4],qr[2],C0,0,0,0),   P1[2],P1[3],P1[4],P1[5],     pw2[0]=PKW(P1,0), pw2[1]=PKW(P1,2), pw2); \
    VRDX(1,0,4); GAPA(C1=__builtin_amdgcn_mfma_f32_32x32x16_bf16(kf[5],qr[2],C1,0,0,0),   P1[6],P1[7],P1[8],P1[9],     pw2[2]=PKW(P1,4), pw2[3]=PKW(P1,6), pw2); \
    VRDX(2,0,1); GAPA(C0=__builtin_amdgcn_mfma_f32_32x32x16_bf16(kf[6],qr[3],C0,0,0,0),   P1[10],P1[11],P1[12],P1[13], pw3[0]=PKW(P1,8), pw3[1]=PKW(P1,10), pw3); \
    VRDX(3,0,5); GAPA(C1=__builtin_amdgcn_mfma_f32_32x32x16_bf16(kf[7],qr[3],C1,0,0,0),   P1[14],P1[15],0.f,0.f,       pw3[2]=PKW(P1,12),pw3[3]=PKW(P1,14), pw3); \
    l_reg+=sacc; \
    if(GK){DMA_K((t)+3,sl_cur);} if(GV){DMA_V((t)+1,sl_next);} \
    CMASK(C0,C1,t); \
    { float a=MX3(C0[0],C0[1],C1[0]),b=MX3(C0[2],C0[3],C1[1]); a=MX3(a,C1[2],C1[3]); \
      _Pragma("unroll") for(int r=4;r<16;r+=4){a=MX3(a,C0[r],C0[r+1]);b=MX3(b,C0[r+2],C0[r+3]);a=MX3(a,C1[r],C1[r+1]);b=MX3(b,C1[r+2],C1[r+3]);} \
      float rm=__builtin_fmaxf(a,b); { auto rr=__builtin_amdgcn_permlane32_swap(__float_as_uint(rm),__float_as_uint(rm),false,false); rm=__builtin_fmaxf(__uint_as_float(rr[0]),__uint_as_float(rr[1])); } \
      resc=false; \
      if(__builtin_expect(__any(rm>(float)THRL),0)){ const float dl=__builtin_fmaxf(rm,0.f); mhat+=dl; \
        _Pragma("unroll") for(int r=0;r<16;++r){C0[r]-=dl;C1[r]-=dl;} \
        _Pragma("unroll") for(int r=0;r<16;++r)negm[r]=-mhat; asm volatile("":"+v"(negm)); \
        const float f=__builtin_amdgcn_exp2f(-dl); l_reg*=f; if(hi==0)wsf[r32]=f; resc=true; } } \
    SBAR(); \
    GAPB2(o[0]=__builtin_amdgcn_mfma_f32_32x32x16_bf16(PAF(0),VFS(0),o[0],0,0,0), C0,0); VRDX(0,0,2); \
    GAPB2(o[1]=__builtin_amdgcn_mfma_f32_32x32x16_bf16(PAF(0),VFS(1),o[1],0,0,0), C0,2); VRDX(1,0,6); \
    KRD(GL,0); GAPB2(o[0]=__builtin_amdgcn_mfma_f32_32x32x16_bf16(PAF(1),VFS(2),o[0],0,0,0), C0,4); VRDX(2,0,3); \
    KRD(GL,1); GAPB2(o[1]=__builtin_amdgcn_mfma_f32_32x32x16_bf16(PAF(1),VFS(3),o[1],0,0,0), C0,6); VRDX(3,0,7); \
    KRD(GL,2); GAPB2(o[0]=__builtin_amdgcn_mfma_f32_32x32x16_bf16(PAF(2),VFS(0),o[0],0,0,0), C0,8); VRDX(0,1,0); \
    KRD(GL,3); GAPB2(o[1]=__builtin_amdgcn_mfma_f32_32x32x16_bf16(PAF(2),VFS(1),o[1],0,0,0), C0,10); VRDX(1,1,4); \
    GAPB2(o[0]=__builtin_amdgcn_mfma_f32_32x32x16_bf16(PAF(3),VFS(2),o[0],0,0,0), C0,12); VRDX(2,1,1); \
    GAPB2(o[1]=__builtin_amdgcn_mfma_f32_32x32x16_bf16(PAF(3),VFS(3),o[1],0,0,0), C0,14); VRDX(3,1,5); \
    GAPB2(o[2]=__builtin_amdgcn_mfma_f32_32x32x16_bf16(PAF(0),VFS(0),o[2],0,0,0), C1,0); VRDX(0,1,2); \
    GAPB2(o[3]=__builtin_amdgcn_mfma_f32_32x32x16_bf16(PAF(0),VFS(1),o[3],0,0,0), C1,2); VRDX(1,1,6); \
    GAPB2(o[2]=__builtin_amdgcn_mfma_f32_32x32x16_bf16(PAF(1),VFS(2),o[2],0,0,0), C1,4); VRDX(2,1,3); \
    GAPB2(o[3]=__builtin_amdgcn_mfma_f32_32x32x16_bf16(PAF(1),VFS(3),o[3],0,0,0), C1,6); VRDX(3,1,7); \
    GAPB2(o[2]=__builtin_amdgcn_mfma_f32_32x32x16_bf16(PAF(2),VFS(0),o[2],0,0,0), C1,8); \
    GAPB2(o[3]=__builtin_amdgcn_mfma_f32_32x32x16_bf16(PAF(2),VFS(1),o[3],0,0,0), C1,10); \
    GAPB2(o[2]=__builtin_amdgcn_mfma_f32_32x32x16_bf16(PAF(3),VFS(2),o[2],0,0,0), C1,12); \
    GAPB2(o[3]=__builtin_amdgcn_mfma_f32_32x32x16_bf16(PAF(3),VFS(3),o[3],0,0,0), C1,14); \
    }while(0)
  int t=1;
  #undef CMASK
  #define CMASK(P0,P1,t) do{}while(0)
  for(;t+5<NT;t+=2){
    STEP(pB0,pB1,pA0,pA1,t,true,true,true);     WAIT_BAR(3); RESC(); ROT();
    STEP(pA0,pA1,pB0,pB1,t+1,true,true,true);   WAIT_BAR(3); RESC(); ROT();
  }
  #undef CMASK
  #define CMASK(P0,P1,t) do{int jb_=(t)-(NT-4); if(jb_>=0)cmask(P0,P1,jb_,qrel,hi);}while(0)
  #define ENDW(tt) do{ if((tt)+3<NT){WAIT_BAR(3);} else if((tt)+2<NT){WAIT_BAR(2);} else {WAIT_BAR(0);} }while(0)
  for(;t+1<NT;t+=2){
    STEP(pB0,pB1,pA0,pA1,t,(t+3<NT),(t+1<NT),(t+1<NT));       ENDW(t);   RESC(); ROT();
    STEP(pA0,pA1,pB0,pB1,t+1,(t+4<NT),(t+2<NT),(t+2<NT));     ENDW(t+1); RESC(); ROT();
  }
  STEP(pB0,pB1,pA0,pA1,NT-1,false,false,false); RESC();
  { float sacc=pB0[0]+pB0[1]; _Pragma("unroll") for(int r=2;r<16;++r)sacc+=pB0[r]; _Pragma("unroll") for(int r=0;r<16;++r)sacc+=pB1[r]; l_reg+=sacc;
    pw0=(u32x4){PKW(pB0,0),PKW(pB0,2),PKW(pB0,4),PKW(pB0,6)};pw1=(u32x4){PKW(pB0,8),PKW(pB0,10),PKW(pB0,12),PKW(pB0,14)};pw2=(u32x4){PKW(pB1,0),PKW(pB1,2),PKW(pB1,4),PKW(pB1,6)};pw3=(u32x4){PKW(pB1,8),PKW(pB1,10),PKW(pB1,12),PKW(pB1,14)};
    SBAR(); { const int vb0=(int)(unsigned)(uintptr_t)vp0; pv(o,vb0+2*sl_cur,PAF(0),PAF(1),PAF(2),PAF(3)); pv(o+2,vb0+2*sl_cur+SLOTB,PAF(0),PAF(1),PAF(2),PAF(3)); } }
  #undef PKW
  #undef PAF
  #undef VFS
  #undef PIN
  #undef MX3
  #undef GAPA
  #undef GAPB
  #undef GAPB2
  #undef VRDX
  #undef EX
  #undef VRD
  #undef KRD
  #undef STEP
  #undef ENDW
  int lane_e=lane; asm volatile("":"+v"(lane_e)); const int r32e=lane_e&31,hie=lane_e>>5;
  {auto rr=__builtin_amdgcn_permlane32_swap(__float_as_uint(l_reg),__float_as_uint(l_reg),false,false);l_reg=__uint_as_float(rr[0])+__uint_as_float(rr[1]);}
  if(hie==0)wsf[32+r32e]=l_reg;asm volatile("s_waitcnt lgkmcnt(0)":::"memory");
  float rli[16];
  #pragma unroll
  for(int r=0;r<16;++r)rli[r]=__builtin_amdgcn_rcpf(wsf[32+crow(r,hie)]);
  bf16*Ow=O+(rowbase+q0+wid*QBLK)*OP+ocol;
  { bf16*stg=(bf16*)(shm+LDS_OST)+wid*2048;
    #pragma unroll
    for(int hh=0;hh<2;++hh){
      #pragma unroll
      for(int r=0;r<16;++r){const int orow=crow(r,hie);
        #pragma unroll
        for(int d0=0;d0<2;++d0)stg[orow*64+d0*32+r32e]=__float2bfloat16(o[2*hh+d0][r]*rli[r]);}
      asm volatile("s_waitcnt lgkmcnt(0)":::"memory");
      #pragma unroll
      for(int i=0;i<4;++i){const int row=i*8+(lane_e>>3),ch=lane_e&7; const u32x4 v=*(const u32x4*)(stg+row*64+ch*8); ATTN_STORE16(Ow+(long)row*OP+hh*64+ch*8,v);}
      asm volatile("s_waitcnt lgkmcnt(0)":::"memory"); } }
  asm volatile("s_waitcnt lgkmcnt(0)\n\ts_barrier":::"memory");
  #undef DMA_K
  #undef DMA_V
  #undef CMASK
  #undef START
  #undef RESC
  #undef ROT
}
constexpr int ATTN_LDS_BYTES=LDS_BYTES;
struct AttnTensors { const bf16* Q; const bf16* K; const bf16* V; bf16* O; };
template<int THRL=8> __device__ __forceinline__ void attn_phase(char*lds,const AttnTensors&T,int vcu,int G,int tid){
  asm volatile("":"+v"(tid));
  const bool bal=(G==256); const int s=vcu&7;
  for(int i=0;;++i){ int bh,qb;
    if(bal){ if(i>=4)break; bh=vcu>>3; qb=(i==0)?s:(i==1)?15-s:(i==2)?16+s:31-s; }
    else{ const int u=vcu+i*G; if(u>=1024)break; qb=31-(u&31); bh=u>>5; }
    const int b=bh>>4,hc=bh&15,hd=hc>>1,c=hc&1;
    attn_unit<THRL>(b,hc,hd*2,c*1024+hd*128,qb,T.Q,T.K,T.V,T.O,lds,tid); }
}
#undef SBAR
#undef WAIT_BAR
}
namespace cg = cooperative_groups;
constexpr int NWAVES = 8;
constexpr int BATCH = 2, SEQ = 8192, DMODEL = 2048, T = BATCH * SEQ, NIN = 17408, BRW = 3584;
constexpr float EPS = 1e-6f;
constexpr size_t MiB = 1u << 20;
constexpr size_t WS_PROJ = 0;
constexpr size_t WS_WIN  = 544 * MiB;
constexpr size_t WS_WBR  = 612 * MiB;
constexpr size_t WS_WOUT = 626 * MiB;
constexpr size_t WS_WKV  = 634 * MiB;
constexpr size_t WS_PW   = 638 * MiB;
constexpr size_t WS_LW   = 638 * MiB + 512 * 1024;
constexpr size_t WS_MEMN = 639 * MiB;
constexpr size_t WS_MK   = 641 * MiB;
constexpr size_t WS_VT   = 641 * MiB + 512 * 1024;
constexpr size_t WS_AGG  = 642 * MiB;
constexpr size_t WS_XN   = 644 * MiB;
constexpr size_t WS_X1   = 708 * MiB;
constexpr size_t WS_BR   = 836 * MiB;
constexpr size_t WS_QKVC = 948 * MiB;
constexpr size_t WS_MISC = 1044 * MiB;
constexpr size_t WS_END  = 1045 * MiB;
constexpr int LDS_BYTES = 147456;
#ifndef MK_MULTI
#define MK_MULTI 0
#endif
#ifndef DBL
#define DBL 0
#endif
#define PH(k) for (int rep_ = 0; rep_ < (((DBL) >> (k)) & 1) + 1; ++rep_) if constexpr (((PHM) >> (k)) & 1)
constexpr size_t WS_BAR = WS_MISC + 65536;
constexpr int MISC_OFF = 131072 + 512;
#define GSYNC() do { if constexpr (((PHM) & ((PHM) - 1)) != 0) { XcdBarrier xb_; xb_.bar = (unsigned*)((unsigned char*)(uintptr_t)karg64(168) + WS_BAR); xb_.x = xb_xcc_id(); \
    xb_.st = (volatile LAS unsigned*)(ldsl + MISC_OFF); xcd_barrier(xb_, MK_TID() == 0); if constexpr (((DBL) >> 15) & 1) { xcd_barrier(xb_, MK_TID() == 0); } } } while (0)
#ifndef DIAG
#define DIAG 0
#endif
#if DIAG
#define TS_OFF (WS_MISC + 131072)
#define STAMP(k) do { unsigned long long* tsp_ = (unsigned long long*)((unsigned char*)(uintptr_t)karg64(168) + TS_OFF); if (blockIdx.x == 0 && threadIdx.x == 0) tsp_[(k)] = __builtin_amdgcn_s_memrealtime(); } while (0)
#else
#define STAMP(k) do { } while (0)
#endif

#define LAS __attribute__((address_space(3)))
typedef unsigned short bf16;
typedef unsigned v4u __attribute__((ext_vector_type(4)));
typedef unsigned v2u __attribute__((ext_vector_type(2)));
typedef float f32x4 __attribute__((ext_vector_type(4)));
typedef float f32x2v __attribute__((ext_vector_type(2)));
typedef short bf16x8 __attribute__((ext_vector_type(8)));
typedef short s16x4 __attribute__((ext_vector_type(4)));
typedef float f32x16 __attribute__((ext_vector_type(16)));
#define LDS_WAIT() asm volatile("s_waitcnt lgkmcnt(0)" ::: "memory")
__device__ __forceinline__ unsigned f2bf(float f) { unsigned u = __builtin_bit_cast(unsigned, f); return (u + 0x7fffu + ((u >> 16) & 1u)) >> 16; }
__device__ __forceinline__ unsigned pk2(float lo, float hi) { return f2bf(lo) | (f2bf(hi) << 16); }
__device__ __forceinline__ float blo(unsigned w) { return __builtin_bit_cast(float, w << 16); }
__device__ __forceinline__ float bhi(unsigned w) { return __builtin_bit_cast(float, w & 0xffff0000u); }
__device__ __forceinline__ float shx(float v, int o, int lane) { return __builtin_bit_cast(float, __builtin_amdgcn_ds_bpermute((lane ^ o) << 2, __builtin_bit_cast(int, v))); }
__device__ __forceinline__ float wave_sum(float v, int lane) {
#pragma unroll
    for (int o = 1; o < 64; o <<= 1) v += shx(v, o, lane);
    return v;
}
__device__ __forceinline__ void p0_transpose_item(const float* W, int K, int N, bf16* WT, int row_off, LAS float* scr, int item, int lane) {
    const int nblk = N / 32, kb = item / nblk, nb = item % nblk, k0 = 64 * kb, n0 = 32 * nb;
    float wv[32];
#pragma unroll
    for (int i = 0; i < 32; ++i) wv[i] = W[(size_t)(k0 + 2 * i + (lane >> 5)) * N + n0 + (lane & 31)];
#pragma unroll
    for (int i = 0; i < 32; ++i) scr[(2 * i + (lane >> 5)) * 33 + (lane & 31)] = wv[i];
    LDS_WAIT(); asm volatile("" ::: "memory");
    const int c = lane & 7;
#pragma unroll
    for (int j = 0; j < 4; ++j) { const int n = (lane >> 3) + 8 * j; const LAS float* s = scr + (8 * c) * 33 + n;
        v4u o; o.x = pk2(s[0 * 33], s[1 * 33]); o.y = pk2(s[2 * 33], s[3 * 33]); o.z = pk2(s[4 * 33], s[5 * 33]); o.w = pk2(s[6 * 33], s[7 * 33]);
        *(v4u*)(WT + (size_t)(row_off + n0 + n) * K + k0 + 8 * c) = o; }
    LDS_WAIT(); asm volatile("" ::: "memory");
}
template <bool OUTF, bool INB = false> __device__ __forceinline__ void rms_rows(const void* x, const float* g, void* out, int first, int step, int nrows, int lane) {
    if (first >= nrows) return;
    f32x4 v[8];
    {
#pragma unroll
      for (int j = 0; j < 8; ++j) { if (INB) { const v2u w = ((const v2u*)((const bf16*)x + (size_t)first * 2048))[lane + 64 * j]; v[j] = (f32x4){blo(w.x), bhi(w.x), blo(w.y), bhi(w.y)}; } else v[j] = ((const f32x4*)((const float*)x + (size_t)first * 2048))[lane + 64 * j]; } }
    for (int m = first; m < nrows; m += step) {
        f32x4 nx[8]; const int mn = (m + step < nrows) ? m + step : m;
        {
#pragma unroll
          for (int j = 0; j < 8; ++j) { if (INB) { const v2u w = ((const v2u*)((const bf16*)x + (size_t)mn * 2048))[lane + 64 * j]; nx[j] = (f32x4){blo(w.x), bhi(w.x), blo(w.y), bhi(w.y)}; } else nx[j] = ((const f32x4*)((const float*)x + (size_t)mn * 2048))[lane + 64 * j]; } }
        float s = 0.f;
#pragma unroll
        for (int j = 0; j < 8; ++j) s += (v[j].x * v[j].x + v[j].y * v[j].y) + (v[j].z * v[j].z + v[j].w * v[j].w);
        const float rstd = 1.0f / sqrtf(wave_sum(s, lane) * (1.0f / 2048.0f) + EPS);
#pragma unroll
        for (int j = 0; j < 8; ++j) { const f32x4 gv = ((const f32x4*)g)[lane + 64 * j]; const f32x4 o = v[j] * rstd * gv;
            if (OUTF) ((f32x4*)((float*)out + (size_t)m * 2048))[lane + 64 * j] = o;
            else { v2u w; w.x = pk2(o.x, o.y); w.y = pk2(o.z, o.w); ((v2u*)((bf16*)out + (size_t)m * 2048))[lane + 64 * j] = w; } }
#pragma unroll
        for (int j = 0; j < 8; ++j) v[j] = nx[j];
    }
}

__device__ __forceinline__ void small_nt_tile(const bf16* A, const bf16* B, bf16* O, int ti, int tj, int lane) {
    const int q = lane & 31, hi = lane >> 5;
    const bf16* ap = A + (size_t)(ti * 32 + q) * 2048 + hi * 8; const bf16* bp = B + (size_t)(tj * 32 + q) * 2048 + hi * 8;
    f32x16 acc = f32x16{};
#pragma unroll 8
    for (int ks = 0; ks < 128; ++ks) { const bf16x8 af = *(const bf16x8*)(ap + ks * 16), bf = *(const bf16x8*)(bp + ks * 16); acc = __builtin_amdgcn_mfma_f32_32x32x16_bf16(af, bf, acc, 0, 0, 0); }
#pragma unroll
    for (int r = 0; r < 16; ++r) { const int i = (r & 3) + 8 * (r >> 2) + 4 * hi; O[(size_t)(ti * 32 + i) * 512 + tj * 32 + q] = (bf16)f2bf(acc[r]); }
}
__device__ __forceinline__ void memattn_unit(const bf16* PROJ, const bf16* MK, const bf16* VT, bf16* BR, int b, int hm, int rb, int lane) {
    const int q = lane & 31, hi = lane >> 5;
    const size_t row = (size_t)b * SEQ + (size_t)rb * 32 + q;
    bf16x8 qf[8];
#pragma unroll
    for (int d0 = 0; d0 < 8; ++d0) qf[d0] = *(const bf16x8*)(PROJ + row * NIN + 5120 + hm * 128 + d0 * 16 + hi * 8);
    const f32x16 zz = f32x16{};
    f32x16 sc[8];
#pragma unroll
    for (int kb = 0; kb < 8; ++kb) { sc[kb] = zz;
        const bf16* kp = MK + (size_t)(b * 256 + kb * 32 + q) * 512 + hm * 128 + hi * 8;
#pragma unroll
        for (int d0 = 0; d0 < 8; ++d0) { const bf16x8 kf = *(const bf16x8*)(kp + d0 * 16); sc[kb] = __builtin_amdgcn_mfma_f32_32x32x16_bf16(kf, qf[d0], sc[kb], 0, 0, 0); }
        __builtin_amdgcn_sched_barrier(0); }
    float mx = -INFINITY;
#pragma unroll
    for (int kb = 0; kb < 8; ++kb)
#pragma unroll
        for (int r = 0; r < 16; ++r) mx = fmaxf(mx, sc[kb][r]);
    mx = fmaxf(mx, shx(mx, 32, lane));
    const float cs = 0.08838834764831845f * 1.4426950408889634f; float l = 0.f;
#pragma unroll
    for (int kb = 0; kb < 8; ++kb)
#pragma unroll
        for (int r = 0; r < 16; ++r) { const float p = __builtin_amdgcn_exp2f((sc[kb][r] - mx) * cs); sc[kb][r] = p; l += p; }
    l += shx(l, 32, lane);
    const float inv = 1.0f / l;
    v4u pk[8][2];
#pragma unroll
    for (int kb = 0; kb < 8; ++kb)
#pragma unroll
        for (int s = 0; s < 2; ++s) {
            pk[kb][s].x = pk2(sc[kb][8 * s + 0] * inv, sc[kb][8 * s + 1] * inv); pk[kb][s].y = pk2(sc[kb][8 * s + 2] * inv, sc[kb][8 * s + 3] * inv);
            pk[kb][s].z = pk2(sc[kb][8 * s + 4] * inv, sc[kb][8 * s + 5] * inv); pk[kb][s].w = pk2(sc[kb][8 * s + 6] * inv, sc[kb][8 * s + 7] * inv); }
#pragma unroll
    for (int kb = 0; kb < 8; ++kb) asm volatile("" : "+v"(pk[kb][0]), "+v"(pk[kb][1]));
    f32x16 o[4]; o[0] = zz; o[1] = zz; o[2] = zz; o[3] = zz;
#pragma unroll
    for (int kb = 0; kb < 8; ++kb)
#pragma unroll
        for (int s = 0; s < 2; ++s) {
            const bf16x8 pb = __builtin_bit_cast(bf16x8, pk[kb][s]);
#pragma unroll
            for (int db = 0; db < 4; ++db) { const bf16* vp = VT + (size_t)(hm * 128 + db * 32 + q) * 512 + b * 256 + kb * 32 + 16 * s + 4 * hi;
                const s16x4 lo = *(const s16x4*)vp, hh = *(const s16x4*)(vp + 8);
                const bf16x8 va = (bf16x8){lo[0], lo[1], lo[2], lo[3], hh[0], hh[1], hh[2], hh[3]};
                o[db] = __builtin_amdgcn_mfma_f32_32x32x16_bf16(va, pb, o[db], 0, 0, 0); }
            __builtin_amdgcn_sched_barrier(0); }
    v2u gwv[4][4];
#pragma unroll
    for (int db = 0; db < 4; ++db)
#pragma unroll
        for (int g4 = 0; g4 < 4; ++g4) gwv[db][g4] = *(const v2u*)(PROJ + row * NIN + 5632 + 3072 + hm * 128 + db * 32 + g4 * 8 + 4 * hi);
#pragma unroll
    for (int db = 0; db < 4; ++db)
#pragma unroll
        for (int g4 = 0; g4 < 4; ++g4) { const int d = hm * 128 + db * 32 + g4 * 8 + 4 * hi;
            const v2u gw = gwv[db][g4];
            v2u w; w.x = pk2(o[db][4 * g4 + 0] * blo(gw.x), o[db][4 * g4 + 1] * bhi(gw.x)); w.y = pk2(o[db][4 * g4 + 2] * blo(gw.y), o[db][4 * g4 + 3] * bhi(gw.y));
            *(v2u*)(BR + row * BRW + 3072 + d) = w; }
}

__device__ __forceinline__ void memattn_stage(const bf16* MK, const bf16* VT, LAS unsigned char* lds, int b, int hm, int tid) {
#pragma unroll
    for (int i = 0; i < 8; ++i) { const int j = tid + 512 * i, key = j >> 4, c = j & 15;
        const v4u v = *(const v4u*)(MK + (size_t)(b * 256 + key) * 512 + hm * 128 + c * 8);
        *(LAS v4u*)(lds + key * 256 + ((c ^ (key & 15)) << 4)) = v; }
#pragma unroll
    for (int i = 0; i < 8; ++i) { const int j = tid + 512 * i, d = j >> 5, c16 = j & 31;
        const v4u v = *(const v4u*)(VT + (size_t)(hm * 128 + d) * 512 + b * 256 + c16 * 8);
        const int p0 = (2 * c16) ^ (d & 31); v2u lo; lo.x = v.x; lo.y = v.y; v2u hi; hi.x = v.z; hi.y = v.w;
        *(LAS v2u*)(lds + 65536 + d * 512 + p0 * 8) = lo; *(LAS v2u*)(lds + 65536 + d * 512 + (p0 ^ 1) * 8) = hi; }
}
__device__ __forceinline__ void memattn_unit_lds(const bf16* PROJ, LAS unsigned char* lds, bf16* BR, int b, int hm, int rb, int lane) {
    const int q = lane & 31, hi = lane >> 5;
    const size_t row = (size_t)b * SEQ + (size_t)rb * 32 + q;
    bf16x8 qf[8];
#pragma unroll
    for (int d0 = 0; d0 < 8; ++d0) qf[d0] = *(const bf16x8*)(PROJ + row * NIN + 5120 + hm * 128 + d0 * 16 + hi * 8);
    const f32x16 zz = f32x16{};
    f32x16 sc[8];
#pragma unroll
    for (int kb = 0; kb < 8; ++kb) { sc[kb] = zz;
        LAS unsigned char* kp = lds + (kb * 32 + q) * 256;
#pragma unroll
        for (int d0 = 0; d0 < 8; ++d0) { const bf16x8 kf = *(LAS bf16x8*)(kp + (((2 * d0 + hi) ^ (q & 15)) << 4)); sc[kb] = __builtin_amdgcn_mfma_f32_32x32x16_bf16(kf, qf[d0], sc[kb], 0, 0, 0); }
        __builtin_amdgcn_sched_barrier(0); }
    float mx = -INFINITY;
#pragma unroll
    for (int kb = 0; kb < 8; ++kb)
#pragma unroll
        for (int r = 0; r < 16; ++r) mx = fmaxf(mx, sc[kb][r]);
    mx = fmaxf(mx, shx(mx, 32, lane));
    const float cs = 0.08838834764831845f * 1.4426950408889634f; float l = 0.f;
#pragma unroll
    for (int kb = 0; kb < 8; ++kb)
#pragma unroll
        for (int r = 0; r < 16; ++r) { const float p = __builtin_amdgcn_exp2f((sc[kb][r] - mx) * cs); sc[kb][r] = p; l += p; }
    l += shx(l, 32, lane);
    const float inv = 1.0f / l;
    v4u pk[8][2];
#pragma unroll
    for (int kb = 0; kb < 8; ++kb)
#pragma unroll
        for (int s = 0; s < 2; ++s) {
            pk[kb][s].x = pk2(sc[kb][8 * s + 0] * inv, sc[kb][8 * s + 1] * inv); pk[kb][s].y = pk2(sc[kb][8 * s + 2] * inv, sc[kb][8 * s + 3] * inv);
            pk[kb][s].z = pk2(sc[kb][8 * s + 4] * inv, sc[kb][8 * s + 5] * inv); pk[kb][s].w = pk2(sc[kb][8 * s + 6] * inv, sc[kb][8 * s + 7] * inv); }
#pragma unroll
    for (int kb = 0; kb < 8; ++kb) asm volatile("" : "+v"(pk[kb][0]), "+v"(pk[kb][1]));
    f32x16 o[4]; o[0] = zz; o[1] = zz; o[2] = zz; o[3] = zz;
#pragma unroll
    for (int kb = 0; kb < 8; ++kb)
#pragma unroll
        for (int s = 0; s < 2; ++s) {
            const bf16x8 pb = __builtin_bit_cast(bf16x8, pk[kb][s]); const int g0 = kb * 8 + 4 * s + hi;
#pragma unroll
            for (int db = 0; db < 4; ++db) { LAS unsigned char* vp = lds + 65536 + (db * 32 + q) * 512;
                const s16x4 lo = *(LAS s16x4*)(vp + ((g0 ^ q) << 3)), hh = *(LAS s16x4*)(vp + (((g0 + 2) ^ q) << 3));
                const bf16x8 va = (bf16x8){lo[0], lo[1], lo[2], lo[3], hh[0], hh[1], hh[2], hh[3]};
                o[db] = __builtin_amdgcn_mfma_f32_32x32x16_bf16(va, pb, o[db], 0, 0, 0); }
            __builtin_amdgcn_sched_barrier(0); }
    v2u gwv[4][4];
#pragma unroll
    for (int db = 0; db < 4; ++db)
#pragma unroll
        for (int g4 = 0; g4 < 4; ++g4) gwv[db][g4] = *(const v2u*)(PROJ + row * NIN + 5632 + 3072 + hm * 128 + db * 32 + g4 * 8 + 4 * hi);
#pragma unroll
    for (int db = 0; db < 4; ++db)
#pragma unroll
        for (int g4 = 0; g4 < 4; ++g4) { const int d = hm * 128 + db * 32 + g4 * 8 + 4 * hi;
            const v2u gw = gwv[db][g4];
            v2u w; w.x = pk2(o[db][4 * g4 + 0] * blo(gw.x), o[db][4 * g4 + 1] * bhi(gw.x)); w.y = pk2(o[db][4 * g4 + 2] * blo(gw.y), o[db][4 * g4 + 3] * bhi(gw.y));
            *(v2u*)(BR + row * BRW + 3072 + d) = w; }
}
#define GAS __attribute__((address_space(1)))
#define RLX_AGENT __ATOMIC_RELAXED, __HIP_MEMORY_SCOPE_AGENT
#define XB_TMO      128
#define XB_XCNT(j)  (256  + 64 * (j))
#define XB_XSUB(j)  (1280 + 64 * (j))
#define XB_XGEN(j)  (2304 + 64 * (j))
#define XB_TOP      3328
#define XB_TOPGEN   3392
#define XCD_BAR_WORDS 3456
#define XB_SPIN_CAP (1u << 23)

__device__ __forceinline__ unsigned xb_ld(unsigned* p)              { return __hip_atomic_load(p, __ATOMIC_RELAXED, __HIP_MEMORY_SCOPE_AGENT); }
__device__ __forceinline__ unsigned xb_add(unsigned* p, unsigned v) { return __hip_atomic_fetch_add(p, v, __ATOMIC_RELAXED, __HIP_MEMORY_SCOPE_AGENT); }
__device__ __forceinline__ unsigned xb_xcc_id() { return (unsigned)__builtin_amdgcn_s_getreg((3 << 11) | 20) & 0xFu; }
#define XB_SPIN(cond, bar) do { unsigned _sp = 0; while (cond) { __builtin_amdgcn_s_sleep(1); \
    if ((++_sp & 255u) == 0u) { if (xb_ld(&(bar)[XB_TMO])) break; if (_sp > XB_SPIN_CAP) { atomicAdd(&(bar)[XB_TMO], 1u); break; } } } } while (0)

struct XcdBarrier {
    unsigned* bar; unsigned x;
    volatile LAS unsigned* st;
};

__device__ __forceinline__ XcdBarrier xcd_barrier_post(unsigned* bar, volatile LAS unsigned* st) {
    XcdBarrier b; b.bar = bar; b.x = xb_xcc_id(); b.st = st;
    if (threadIdx.x == 0)     (void)xb_add(&bar[XB_XCNT(b.x)], 1u);
    return b;
}
__device__ __forceinline__ void xcd_barrier_complete(unsigned* bar, unsigned x, unsigned& nloc, unsigned& nx) {
    const unsigned G = gridDim.x * gridDim.y * gridDim.z;
    unsigned sum, cnt, mine, sp = 0u;
    for (;;) {
        sum = 0u; cnt = 0u; mine = 0u;
#pragma unroll
        for (unsigned j = 0; j < 16; ++j) { const unsigned c = xb_ld(&bar[XB_XCNT(j)]); sum += c; cnt += (c > 0u) ? 1u : 0u; mine = (j == x) ? c : mine; }
        if (sum == G) break;
        __builtin_amdgcn_s_sleep(1);
        if ((++sp & 255u) == 0u) { if (xb_ld(&bar[XB_TMO])) break; if (sp > XB_SPIN_CAP) { atomicAdd(&bar[XB_TMO], 1u); break; } }
    }
    nloc = mine > 0u ? mine : 1u; nx = cnt > 0u ? cnt : 1u;
}

__device__ __forceinline__ void xcd_barrier(const XcdBarrier& b, const bool leader) {
    asm volatile("s_waitcnt vmcnt(0)" ::: "memory");
    __syncthreads();
    if (leader) {
        unsigned* bar = b.bar;
        __builtin_amdgcn_s_waitcnt(0);
        unsigned nloc = b.st[0], nx = b.st[1];
        if (nloc == 0u) { xcd_barrier_complete(bar, b.x, nloc, nx); b.st[0] = nloc; b.st[1] = nx; }
        const unsigned old = xb_add(&bar[XB_XSUB(b.x)], 1u);
        const unsigned gen = old / nloc;
        if (old + 1u == (gen + 1u) * nloc) {
            __builtin_amdgcn_fence(__ATOMIC_RELEASE, "agent");
            asm volatile("s_waitcnt vmcnt(0)" ::: "memory");
            const unsigned og = xb_add(&bar[XB_TOP], 1u);
            const unsigned tg = og / nx;
            if (og + 1u == (tg + 1u) * nx) xb_add(&bar[XB_TOPGEN], 1u);
            else XB_SPIN(xb_ld(&bar[XB_TOPGEN]) == tg, bar);
            __builtin_amdgcn_fence(__ATOMIC_ACQUIRE, "agent");
            xb_add(&bar[XB_XGEN(b.x)], 1u);
            asm volatile("s_waitcnt vmcnt(0)" ::: "memory");
        } else {
            XB_SPIN(xb_ld(&bar[XB_XGEN(b.x)]) == gen, bar);
            __builtin_amdgcn_fence(__ATOMIC_ACQUIRE, "agent");
            asm volatile("s_waitcnt vmcnt(0)" ::: "memory");
        }
    }
    __syncthreads();
}
__device__ __forceinline__ int mk_lane() { unsigned z = 0u; asm volatile("v_mov_b32 %0, 0" : "=v"(z)); return (int)__builtin_amdgcn_mbcnt_hi(~0u, __builtin_amdgcn_mbcnt_lo(~0u, z)); }
struct Args { const float* in[20]; float* out; unsigned char* ws; };
#define CAS __attribute__((address_space(4)))
__device__ __forceinline__ unsigned long long karg64(int byte_off) {
    const CAS char* p = (const CAS char*)__builtin_amdgcn_kernarg_segment_ptr(); asm volatile("" : "+s"(p));
    return *(const CAS unsigned long long*)(p + byte_off);
}
__device__ __forceinline__ const float* getp(int k) { return (const float*)(uintptr_t)karg64(8 * k); }
template <int PART> __device__ __forceinline__ void p0_weights(const int l, bf16* WIN, bf16* WBR, bf16* WOUT, bf16* WKV, bf16* PW, bf16* LW, LAS float* scr, int gw, int NGW, int lane) {
    const float* w_in = getp(3) + (size_t)l * 2048 * NIN; const float* pool_w = getp(6) + (size_t)l * 4 * 65536;
    const float* lru_wa = getp(10) + (size_t)l * 8 * 16384; const float* lru_wx = getp(12) + (size_t)l * 8 * 16384;
    const float* w_kv = getp(16) + (size_t)l * 2048 * 1024; const float* w_br = getp(17) + (size_t)l * BRW * 2048; const float* w_out = getp(18) + (size_t)l * 2048 * 2048;
    constexpr int I_IN = 32 * 544, I_BR = 56 * 64, I_OUT = 32 * 64, I_KV = 32 * 32, I_PW = 4 * 32, I_LW = 8 * 8;
    if (PART == 2) { for (int it = gw; it < I_OUT; it += NGW) p0_transpose_item(w_out, 2048, 2048, WOUT, 0, scr, it, lane); return; }
    constexpr int NITEMS = I_IN + I_BR + (PART == 0 ? I_OUT : 0) + I_KV + I_PW + 2 * I_LW;
    for (int it = gw; it < NITEMS; it += NGW) {
        int r = it;
        if (r < I_IN) { p0_transpose_item(w_in, 2048, NIN, WIN, 0, scr, r, lane); continue; } r -= I_IN;
        if (r < I_BR) { p0_transpose_item(w_br, BRW, 2048, WBR, 0, scr, r, lane); continue; } r -= I_BR;
        if (PART == 0) { if (r < I_OUT) { p0_transpose_item(w_out, 2048, 2048, WOUT, 0, scr, r, lane); continue; } r -= I_OUT; }
        if (r < I_KV) { p0_transpose_item(w_kv, 2048, 1024, WKV, 0, scr, r, lane); continue; } r -= I_KV;
        if (r < I_PW) { const int g = r / 32; p0_transpose_item(pool_w + g * 65536, 256, 256, PW + g * 65536, 0, scr, r % 32, lane); continue; } r -= I_PW;
        if (r < I_LW) { const int g = r / 8; p0_transpose_item(lru_wa + g * 16384, 128, 128, LW + g * 32768, 0, scr, r % 8, lane); continue; } r -= I_LW;
        { const int g = r / 8; p0_transpose_item(lru_wx + g * 16384, 128, 128, LW + g * 32768, 128, scr, r % 8, lane); }
    }
}
template <int PHM> __device__ __forceinline__ void layer_body(unsigned char* lds, LAS unsigned char* ldsl, cg::grid_group& grid, const int l, const int wave_s) {
#define MK_TID() (wave_s * 64 + mk_lane())
#define PHASE_IDS() int tid = MK_TID(); asm volatile("" : "+v"(tid)); int G = gridDim.x, bx = blockIdx.x; asm volatile("" : "+s"(G), "+s"(bx)); \
    unsigned char* ws = (unsigned char*)(uintptr_t)karg64(168); float* outp = (float*)(uintptr_t)karg64(160); \
    const int vcu = (G % 8 == 0) ? (bx % 8) * (G / 8) + bx / 8 : bx, NGW = G * NWAVES, NGT = G * NWAVES * 64; \
    const int lane = tid & 63, wave = __builtin_amdgcn_readfirstlane(tid >> 6), gw = vcu * NWAVES + wave, gt = vcu * (NWAVES * 64) + tid; \
    bf16* PROJ = (bf16*)(ws + WS_PROJ); bf16* WIN = (bf16*)(ws + WS_WIN); bf16* WBR = (bf16*)(ws + WS_WBR); bf16* WOUT = (bf16*)(ws + WS_WOUT); bf16* WKV = (bf16*)(ws + WS_WKV); \
    bf16* PW = (bf16*)(ws + WS_PW); bf16* LW = (bf16*)(ws + WS_LW); bf16* MEMN = (bf16*)(ws + WS_MEMN); bf16* MK = (bf16*)(ws + WS_MK); bf16* VT = (bf16*)(ws + WS_VT); \
    float* AGGP = (float*)(ws + WS_AGG); float* AGGH = AGGP + 256 * 1024; float* SPB = (float*)(ws + WS_MISC); \
    bf16* XN = (bf16*)(ws + WS_XN); bf16* AO = XN; bf16* MB = XN; bf16* X1 = (bf16*)(ws + WS_X1); bf16* BR = (bf16*)(ws + WS_BR); bf16* DP = (bf16*)((unsigned char*)outp + 64 * MiB); bf16* XC = (bf16*)((unsigned char*)outp + 96 * MiB); bf16* QKVC = (bf16*)(ws + WS_QKVC); \
    bf16* LAB = (bf16*)outp; bf16* UBB = LAB + (size_t)T * 1024; \
    (void)lane; (void)wave; (void)gw; (void)gt; (void)NGW; (void)NGT; (void)PROJ; (void)WIN; (void)WBR; (void)WOUT; (void)WKV; (void)PW; (void)LW; (void)MEMN; (void)MK; (void)VT; (void)AGGP; (void)AGGH; (void)SPB; \
    (void)XN; (void)AO; (void)MB; (void)X1; (void)BR; (void)DP; (void)XC; (void)LAB; (void)UBB; (void)QKVC
#define GETP(k) getp(k)

        const float lambda_init = (l == 0) ? 0.2f : 0.35550906759f;

        PH(0) { PHASE_IDS();
            LAS float* scr = (LAS float*)(ldsl + wave * 16384);
            const float* mem = GETP(1);
            const float* norm_g = GETP(2) + l * 2048; const float* lru_lam = GETP(14) + l * 1024; const float* mem_g = GETP(15) + l * 2048;
            if (l == 0) p0_weights<0>(0, WIN, WBR, WOUT, WKV, PW, LW, scr, gw, NGW, lane);
            else        p0_weights<2>(1, WIN, WBR, WOUT, WKV, PW, LW, scr, gw, NGW, lane);
            if (l == 0) rms_rows<false, false>(GETP(0), norm_g, XN, gw, NGW, T, lane); else rms_rows<false, true>(X1, norm_g, XN, gw, NGW, T, lane);
            if (l == 0) { rms_rows<false>(mem, mem_g, MEMN, gw, NGW, 512, lane);
                if (gt < 1024) SPB[gt] = -8.0f * 1.4426950408889634f * log1pf(__expf(-lru_lam[gt])); }
        }
        GSYNC(); STAMP(l * 8 + 1);

        PH(1) { PHASE_IDS();
            pg8::Gemm g{XN, WIN, T, NIN, 2048, 2048, 2048, 1, 0, 0}; pg8::StaticOrder S; S.init(T, NIN, G, bx);
            pg8::EpiBf16Act E{PROJ, NIN, 1, QKVC};
            pg8::gemm_phase<pg8::EpiBf16Act, pg8::StaticOrder, true, true>(ldsl, g, S, E, tid);
        }
        GSYNC(); STAMP(l * 8 + 2);

        PH(2) { PHASE_IDS(); const float* conv_w = GETP(8) + l * 4096; const float* conv_b = GETP(9) + l * 1024;
        for (int u = gw; u < 2048; u += NGW) { if ((u & 3) == 0) { const int t2 = u >> 2, ti = (t2 >> 4) & 15, tj = t2 & 15;
            if (t2 < 256) small_nt_tile(MEMN, WKV, MK, ti, tj, lane); else small_nt_tile(WKV + (size_t)512 * 2048, MEMN, VT, ti, tj, lane); } }
        for (int it = gt; it < T * 128; it += NGT) {
            const int idx = it & 255, grp = __builtin_amdgcn_readfirstlane(idx >> 6), l6 = idx & 63, row = 2 * (it >> 8) + (l6 >> 5), ck = grp * 32 + (l6 & 31), t = row & (SEQ - 1), ch = ck * 8;
            v4u cv[4];
#pragma unroll
            for (int j = 0; j < 4; ++j) { const int back = 3 - j; const int bb = (back <= t) ? back : t; cv[j] = *(const v4u*)(PROJ + (size_t)row * NIN + 4096 + ch - (size_t)bb * NIN); }
            {
                const bf16* p = PROJ + (size_t)row * NIN + 3072 + ch; float s[8] = {0.f, 0.f, 0.f, 0.f, 0.f, 0.f, 0.f, 0.f}; float x0[8];
#define POOL_ACC(W) _Pragma("unroll") for (int u = 0; u < (W); ++u) { const int uu = (u <= t) ? u : t; const float wgt = (u <= t) ? 1.0f : 0.0f; const v4u v = *(const v4u*)(p - (size_t)uu * NIN); \
                    const float f[8] = {blo(v.x), bhi(v.x), blo(v.y), bhi(v.y), blo(v.z), bhi(v.z), blo(v.w), bhi(v.w)}; \
                    _Pragma("unroll") for (int j = 0; j < 8; ++j) { s[j] += wgt * f[j]; if (u == 0) x0[j] = f[j]; } }
                int w;
                if (grp == 0) { w = 2; POOL_ACC(2) } else if (grp == 1) { w = 4; POOL_ACC(4) } else if (grp == 2) { w = 8; POOL_ACC(8) } else { w = 16; POOL_ACC(16) }
#undef POOL_ACC
                const int cnt = (t + 1 < w) ? t + 1 : w; const float ic = 1.0f / (float)cnt; v4u o;
                o.x = pk2(s[0] * ic - x0[0], s[1] * ic - x0[1]); o.y = pk2(s[2] * ic - x0[2], s[3] * ic - x0[3]); o.z = pk2(s[4] * ic - x0[4], s[5] * ic - x0[5]); o.w = pk2(s[6] * ic - x0[6], s[7] * ic - x0[7]);
                *(v4u*)(DP + (size_t)row * 1024 + ch) = o;
            }
            {
                float s[8];
                { const f32x4 b0 = *(const f32x4*)(conv_b + ch), b1 = *(const f32x4*)(conv_b + ch + 4); s[0] = b0.x; s[1] = b0.y; s[2] = b0.z; s[3] = b0.w; s[4] = b1.x; s[5] = b1.y; s[6] = b1.z; s[7] = b1.w; }
#pragma unroll
                for (int j = 0; j < 4; ++j) { const int back = 3 - j; const float wgt = (back <= t) ? 1.0f : 0.0f; const v4u v = cv[j];
                    const f32x4 w0 = *(const f32x4*)(conv_w + j * 1024 + ch) * wgt, w1 = *(const f32x4*)(conv_w + j * 1024 + ch + 4) * wgt;
                    s[0] += w0.x * blo(v.x); s[1] += w0.y * bhi(v.x); s[2] += w0.z * blo(v.y); s[3] += w0.w * bhi(v.y); s[4] += w1.x * blo(v.z); s[5] += w1.y * bhi(v.z); s[6] += w1.z * blo(v.w); s[7] += w1.w * bhi(v.w); }
                v4u o; o.x = pk2(s[0], s[1]); o.y = pk2(s[2], s[3]); o.z = pk2(s[4], s[5]); o.w = pk2(s[6], s[7]);
                *(v4u*)(XC + (size_t)row * 1024 + ch) = o;
            }
        } }
        GSYNC(); STAMP(l * 8 + 3);

        PH(3) { int G = gridDim.x, bx = blockIdx.x; asm volatile("" : "+s"(G), "+s"(bx)); const int vcu = (G % 8 == 0) ? (bx % 8) * (G / 8) + bx / 8 : bx;
            unsigned char* ws = (unsigned char*)(uintptr_t)karg64(168); bf16* QKVC = (bf16*)(ws + WS_QKVC); bf16* AO = (bf16*)(ws + WS_XN);
            const attn_body::AttnTensors AT{(const attn_body::bf16*)QKVC, (const attn_body::bf16*)(QKVC + (size_t)T * 1024), (const attn_body::bf16*)(QKVC + (size_t)2 * T * 1024), (attn_body::bf16*)AO};
            attn_body::attn_phase<8>((char*)lds, AT, vcu, G, MK_TID());
            __syncthreads();
        }
        PH(9) { PHASE_IDS();
            pg8::Gemm gp{DP, PW, T, 256, 256, 1024, 256, 4, 512, 131072}; pg8::StaticOrder Sp; Sp.init(T, 256, G, bx, 4);
            pg8::EpiPool Ep{BR, GETP(7) + l * 1024, PROJ};
            pg8::gemm_phase<pg8::EpiPool, pg8::StaticOrder, true, true>(ldsl, gp, Sp, Ep, tid);
        }
        PH(10) { PHASE_IDS();
            pg8::Gemm gl{XC, LW, T, 256, 128, 1024, 128, 8, 256, 65536}; pg8::StaticOrder Sl; Sl.init(T, 256, G, bx, 8);
            pg8::EpiLru El{XC, GETP(11) + l * 1024, GETP(13) + l * 1024, SPB, LAB, UBB};
            pg8::gemm_phase<pg8::EpiLru, pg8::StaticOrder, true, true>(ldsl, gl, Sl, El, tid);
        }
        PH(11) { PHASE_IDS();
            if (G == 256) {
                const int u0 = vcu * 8, b = u0 >> 10, hm = (u0 >> 8) & 3;
                __syncthreads(); memattn_stage(MK, VT, ldsl, b, hm, tid); __syncthreads();
                memattn_unit_lds(PROJ, ldsl, BR, b, hm, (u0 & 255) + wave, lane);
                __syncthreads();
            } else
            for (int u = gw; u < 2048; u += NGW) memattn_unit(PROJ, MK, VT, BR, u >> 10, (u >> 8) & 3, u & 255, lane);
        }
        GSYNC(); STAMP(l * 8 + 4);

        PH(4) { PHASE_IDS();
            float lam; const float* lam_vecs = GETP(4) + l * 256; const float* subln_g = GETP(5) + l * 128;
            { const float p1 = lam_vecs[lane] * lam_vecs[64 + lane], p2 = lam_vecs[128 + lane] * lam_vecs[192 + lane];
              lam = __expf(wave_sum(p1, lane)) - __expf(wave_sum(p2, lane)) + lambda_init; }
            const float osc = 1.0f - lambda_init;
            for (int m0 = gw; m0 < T; m0 += 2 * NGW) {
                v4u va[2][2][2], vg[2][2];
#pragma unroll
                for (int rr = 0; rr < 2; ++rr) { const int m = (m0 + rr * NGW < T) ? m0 + rr * NGW : m0; const bf16* a0 = AO + (size_t)m * 2048 + lane * 16; const bf16* gp = PROJ + (size_t)m * NIN + 5632 + lane * 16;
#pragma unroll
                    for (int h2 = 0; h2 < 2; ++h2) { va[rr][h2][0] = *(const v4u*)(a0 + h2 * 8); va[rr][h2][1] = *(const v4u*)(a0 + 1024 + h2 * 8); vg[rr][h2] = *(const v4u*)(gp + h2 * 8); } }
#pragma unroll
                for (int rr = 0; rr < 2; ++rr) { const int m = m0 + rr * NGW; if (m < T) {
                    float d[16]; float ss = 0.f;
#pragma unroll
                    for (int h2 = 0; h2 < 2; ++h2) { const v4u v0 = va[rr][h2][0], v1 = va[rr][h2][1];
                        const float f0[8] = {blo(v0.x), bhi(v0.x), blo(v0.y), bhi(v0.y), blo(v0.z), bhi(v0.z), blo(v0.w), bhi(v0.w)};
                        const float f1[8] = {blo(v1.x), bhi(v1.x), blo(v1.y), bhi(v1.y), blo(v1.z), bhi(v1.z), blo(v1.w), bhi(v1.w)};
#pragma unroll
                        for (int j = 0; j < 8; ++j) { const float df = f0[j] - lam * f1[j]; d[h2 * 8 + j] = df; ss += df * df; } }
                    ss += shx(ss, 1, lane); ss += shx(ss, 2, lane); ss += shx(ss, 4, lane);
                    const float rstd = osc / sqrtf(ss * (1.0f / 128.0f) + EPS);
                    const int c0 = (lane & 7) * 16;
#pragma unroll
                    for (int h2 = 0; h2 < 2; ++h2) { const v4u gv = vg[rr][h2];
                        const float gf[8] = {blo(gv.x), bhi(gv.x), blo(gv.y), bhi(gv.y), blo(gv.z), bhi(gv.z), blo(gv.w), bhi(gv.w)};
                        const f32x4 s0 = *(const f32x4*)(subln_g + c0 + h2 * 8), s1 = *(const f32x4*)(subln_g + c0 + h2 * 8 + 4);
                        const float sg[8] = {s0.x, s0.y, s0.z, s0.w, s1.x, s1.y, s1.z, s1.w}; float y[8];
#pragma unroll
                        for (int j = 0; j < 8; ++j) y[j] = d[h2 * 8 + j] * rstd * sg[j] * gf[j];
                        v4u o; o.x = pk2(y[0], y[1]); o.y = pk2(y[2], y[3]); o.z = pk2(y[4], y[5]); o.w = pk2(y[6], y[7]);
                        *(v4u*)(BR + (size_t)m * BRW + lane * 16 + h2 * 8) = o; } } }
            }
            for (int u = gw; u < 2048; u += NGW) { const int sg = u >> 3, ch = (u & 7) * 128 + lane * 2; const size_t base = (size_t)sg * 64 * 1024 + ch;
                float h0 = 0.f, h1 = 0.f, L0 = 0.f, L1 = 0.f;
#pragma unroll 16
                for (int t = 0; t < 64; ++t) { const unsigned lw = *(const unsigned*)(LAB + base + (size_t)t * 1024), uw = *(const unsigned*)(UBB + base + (size_t)t * 1024);
                    const float l0 = blo(lw), l1 = bhi(lw); h0 = __builtin_amdgcn_exp2f(l0) * h0 + blo(uw); h1 = __builtin_amdgcn_exp2f(l1) * h1 + bhi(uw); L0 += l0; L1 += l1; }
                f32x2v pv; pv.x = __builtin_amdgcn_exp2f(L0); pv.y = __builtin_amdgcn_exp2f(L1); f32x2v hv; hv.x = h0; hv.y = h1;
                *(f32x2v*)(AGGP + sg * 1024 + ch) = pv; *(f32x2v*)(AGGH + sg * 1024 + ch) = hv; }
        }
        GSYNC(); STAMP(l * 8 + 5);

        PH(5) { PHASE_IDS(); for (int u = gw; u < 2048; u += NGW) { const int sg = u >> 3, ch = (u & 7) * 128 + lane * 2; const size_t base = (size_t)sg * 64 * 1024 + ch;
            float h0 = 0.f, h1 = 0.f;
#pragma unroll 16
            for (int s2 = sg & ~127; s2 < sg; ++s2) { const f32x2v p = *(const f32x2v*)(AGGP + s2 * 1024 + ch), hh = *(const f32x2v*)(AGGH + s2 * 1024 + ch); h0 = p.x * h0 + hh.x; h1 = p.y * h1 + hh.y; }
#pragma unroll 1
            for (int t0 = 0; t0 < 64; t0 += 16) {
                unsigned lw[16], uw[16], gg[16], ow[16];
#pragma unroll
                for (int i = 0; i < 16; ++i) { const size_t row = (size_t)sg * 64 + t0 + i; lw[i] = *(const unsigned*)(LAB + base + (size_t)(t0 + i) * 1024); uw[i] = *(const unsigned*)(UBB + base + (size_t)(t0 + i) * 1024);
                    gg[i] = *(const unsigned*)(PROJ + row * NIN + 5632 + 2048 + ch); }
#pragma unroll
                for (int i = 0; i < 16; ++i) { h0 = __builtin_amdgcn_exp2f(blo(lw[i])) * h0 + blo(uw[i]); h1 = __builtin_amdgcn_exp2f(bhi(lw[i])) * h1 + bhi(uw[i]); ow[i] = pk2(h0 * blo(gg[i]), h1 * bhi(gg[i])); }
#pragma unroll
                for (int i = 0; i < 16; ++i) { const size_t row = (size_t)sg * 64 + t0 + i; *(unsigned*)(BR + row * BRW + 2048 + ch) = ow[i]; }
            }
        } }
        GSYNC(); STAMP(l * 8 + 6);

        PH(6) { PHASE_IDS();
            pg8::Gemm g{BR, WBR, T, 2048, BRW, BRW, BRW, 1, 0, 0}; pg8::StaticOrder S; S.init(T, 2048, G, bx);
            pg8::EpiBranchFused E{PROJ + 9216, MB};
            pg8::gemm_phase<pg8::EpiBranchFused, pg8::StaticOrder, true, true>(ldsl, g, S, E, tid);
        }
        GSYNC(); STAMP(l * 8 + 7);

        PH(7) { PHASE_IDS();
            pg8::Gemm g{MB, WOUT, T, 2048, 2048, 2048, 2048, 1, 0, 0}; pg8::StaticOrder S; S.init(T, 2048, G, bx);
            if (l == 0) { pg8::EpiRes<false, true> E{GETP(0), X1, 2048}; pg8::gemm_phase<pg8::EpiRes<false, true>, pg8::StaticOrder, true, true>(ldsl, g, S, E, tid); }
            else { pg8::EpiRes<true, false> E{X1, outp, 2048}; pg8::gemm_phase<pg8::EpiRes<true, false>, pg8::StaticOrder, true, true>(ldsl, g, S, E, tid); }
            if (l == 0) {
                LAS float* scr = (LAS float*)(ldsl + wave * 16384);
                p0_weights<1>(1, WIN, WBR, WOUT, WKV, PW, LW, scr, gw, NGW, lane);
                rms_rows<false>(GETP(1), GETP(15) + 2048, MEMN, gw, NGW, 512, lane);
                if (gt < 1024) SPB[gt] = -8.0f * 1.4426950408889634f * log1pf(__expf(-(GETP(14) + 1024)[gt]));
            }
        }
        GSYNC(); STAMP(l * 8 + 8);
}
template <int PHM> __global__ void __launch_bounds__(NWAVES * 64, 2) mk_fwd(Args args, int l0, int l1) {
    extern __shared__ __attribute__((aligned(16))) unsigned char lds[];
    cg::grid_group grid = cg::this_grid();
    LAS unsigned char* ldsl = (LAS unsigned char*)lds;
    (void)args; (void)ldsl;
    const int wave_s = __builtin_amdgcn_readfirstlane((int)threadIdx.x >> 6);
    if constexpr (((PHM) & ((PHM) - 1)) != 0) {
        if (threadIdx.x < 2) ((volatile LAS unsigned*)(ldsl + MISC_OFF))[threadIdx.x] = 0u;
        __syncthreads();
        (void)xcd_barrier_post((unsigned*)((unsigned char*)(uintptr_t)karg64(168) + WS_BAR), (volatile LAS unsigned*)(ldsl + MISC_OFF));
        if (l1 == 0x7fffffff) grid.sync();
    }
    STAMP(0);
    if constexpr (((PHM) & ((PHM) - 1)) != 0) { layer_body<PHM>(lds, ldsl, grid, 0, wave_s); layer_body<PHM>(lds, ldsl, grid, 1, wave_s); }
    else if constexpr (PHM != 0x100) layer_body<PHM>(lds, ldsl, grid, l0, wave_s);
    PH(8) { PHASE_IDS(); rms_rows<true>(outp, GETP(19), outp, gw, NGW, T, lane); }
#if DIAG
    GSYNC(); STAMP(17);
    GSYNC();
    {
        const unsigned long long* ts = (const unsigned long long*)((unsigned char*)(uintptr_t)karg64(168) + TS_OFF);
        float* o = (float*)(uintptr_t)karg64(160);
        int tid = threadIdx.x; asm volatile("" : "+v"(tid));
        const float A = (float)(unsigned)(ts[DIAG_A_HI] - ts[DIAG_A_LO]) * 0.01f, B = (float)(unsigned)(ts[DIAG_B_HI] - ts[DIAG_B_LO]) * 0.01f;
        const int n2 = (int)(B * 10000.0f) < 33000000 ? (int)(B * 10000.0f) : 33000000;
        const int gt_ = (int)blockIdx.x * 512 + tid, NT_ = (int)gridDim.x * 512;
        for (int i = gt_; i < n2; i += NT_) o[4096 + i] += 2.0f;
        if (gt_ == 0) o[0] = A;
    }
#endif
}

extern "C" void kernel_launch(void* const* d_in, const int* in_sizes, int n_in, void* d_out, int out_size, void* d_ws, size_t ws_size, hipStream_t stream) {
    static int grid = 0;
    if (grid == 0) {
        if (n_in != 20 || out_size != T * DMODEL || ws_size < WS_END) { fprintf(stderr, "kernel_launch: unexpected shapes / workspace (n_in %d out %d ws %zu, need %zu)\n", n_in, out_size, ws_size, (size_t)WS_END); grid = -1; return; }
        int dev = 0, cus = 0, per_cu = 0;
        if (hipGetDevice(&dev) != hipSuccess || hipDeviceGetAttribute(&cus, hipDeviceAttributeMultiprocessorCount, dev) != hipSuccess) { grid = -1; return; }
#if !MK_MULTI
        if (hipFuncSetAttribute((const void*)mk_fwd<0xfff>, hipFuncAttributeMaxDynamicSharedMemorySize, LDS_BYTES) != hipSuccess) { grid = -1; return; }
        if (hipOccupancyMaxActiveBlocksPerMultiprocessor(&per_cu, (const void*)mk_fwd<0xfff>, NWAVES * 64, LDS_BYTES) != hipSuccess || per_cu < 1) { fprintf(stderr, "kernel_launch: occupancy query says %d\n", per_cu); }
#endif
        (void)per_cu;
        (void)hipGetLastError();
        grid = cus;
    }
    if (grid < 0) return;
    Args a{};
    for (int i = 0; i < 20; ++i) a.in[i] = (const float*)d_in[i];
    a.out = (float*)d_out; a.ws = (unsigned char*)d_ws;
#if MK_MULTI
#define LAUNCH1(MASK, L0, L1) do { static bool once_##MASK = false; if (!once_##MASK) { (void)hipFuncSetAttribute((const void*)mk_fwd<MASK>, hipFuncAttributeMaxDynamicSharedMemorySize, LDS_BYTES); once_##MASK = true; } \
        hipLaunchKernelGGL(mk_fwd<MASK>, dim3(grid), dim3(NWAVES * 64), LDS_BYTES, stream, a, (L0), (L1)); } while (0)
    for (int l = 0; l < 2; ++l) {
        LAUNCH1(0x001, l, l + 1); LAUNCH1(0x002, l, l + 1); LAUNCH1(0x004, l, l + 1); LAUNCH1(0x008, l, l + 1); LAUNCH1(0x200, l, l + 1); LAUNCH1(0x400, l, l + 1); LAUNCH1(0x800, l, l + 1);
        LAUNCH1(0x010, l, l + 1); LAUNCH1(0x020, l, l + 1); LAUNCH1(0x040, l, l + 1); LAUNCH1(0x080, l, l + 1);
    }
    LAUNCH1(0x100, 0, 0);
#else
    if (hipMemsetAsync((char*)d_ws + WS_BAR, 0, 16384, stream) != hipSuccess) { fprintf(stderr, "kernel_launch: memset of the barrier words failed\n"); return; }
    int l0 = 0, l1 = 2;
    void* kargs[] = {&a, &l0, &l1};
    hipError_t e = hipLaunchCooperativeKernel((const void*)mk_fwd<0xfff>, dim3(grid), dim3(NWAVES * 64), kargs, LDS_BYTES, stream);
    if (e != hipSuccess) fprintf(stderr, "kernel_launch: cooperative launch failed: %s (grid %d)\n", hipGetErrorString(e), grid);
#endif
}
```
